# Optimizing an MI355X kernel written in HIP

```python
import jax
import jax.numpy as jnp
from jax import lax
import numpy as np

D_MODEL = 1024
BATCH = 8
SEQ = 2048
DEPTH = 1

ATT_HEADS = 16
ATT_HEAD_DIM = 64
ATT_W = ATT_HEADS * ATT_HEAD_DIM
DILATED_PATTERNS = ((128, 1), (512, 4), (2048, 16))
ROPE_THETA = 10000.0
RET_HEADS = 4
RET_QK_DIM = 256
RET_V_DIM = 512
RET_QK_W = RET_HEADS * RET_QK_DIM
RET_V_W = RET_HEADS * RET_V_DIM
RET_CHUNK = 128
N_GROUPS = 4
EXPERTS_PER_GROUP = 8
N_EXPERTS = N_GROUPS * EXPERTS_PER_GROUP
TOP_K_IN_GROUP = 2
EXPERT_FF = 256
EPS = 1e-6
IN_SPLITS = (ATT_W, ATT_W, ATT_W, RET_QK_W, RET_QK_W, RET_V_W, RET_V_W, D_MODEL, D_MODEL)
IN_WIDTH = sum(IN_SPLITS)

kernel_name = 'hybrid_dilated_retention_hmoe_block'


def _split_points():
    pts, acc = [], 0
    for s in IN_SPLITS[:-1]:
        acc += s
        pts.append(acc)
    return pts


def _rmsnorm(x, g):
    xf = x.astype(jnp.float32)
    y = xf * lax.rsqrt(jnp.mean(xf * xf, axis=-1, keepdims=True) + EPS)
    return (y * g.astype(jnp.float32)).astype(x.dtype)


def _rotate(x, pos, inv_freq):
    ang = pos[:, None] * inv_freq[None, :]
    cos, sin = jnp.cos(ang), jnp.sin(ang)
    x1, x2 = jnp.split(x, 2, axis=-1)
    return jnp.concatenate([x1 * cos - x2 * sin, x2 * cos + x1 * sin], axis=-1)


def _heads(t, n, d):
    B, S, _ = t.shape
    return t.reshape(B, S, n, d).transpose(0, 2, 1, 3)


def _merge_heads(t):
    B, H, S, d = t.shape
    return t.transpose(0, 2, 1, 3).reshape(B, S, H * d)


def _dilated_pattern(q, k, v, window, dilation):
    B, H, S, hd = q.shape
    L = window // dilation
    Sr = S // dilation
    nb = -(-Sr // L)
    pad = nb * L - Sr

    def to_blocks(t):
        t = t.reshape(B, H, Sr, dilation, hd).transpose(0, 1, 3, 2, 4)
        t = jnp.pad(t, ((0, 0), (0, 0), (0, 0), (0, pad), (0, 0)))
        return t.reshape(B, H, dilation, nb, L, hd)

    def with_prev(t):
        prev = jnp.pad(t[:, :, :, :-1], ((0, 0), (0, 0), (0, 0), (1, 0), (0, 0), (0, 0)))
        return jnp.concatenate([prev, t], axis=4)

    qb = to_blocks(q)
    k2 = with_prev(to_blocks(k))
    v2 = with_prev(to_blocks(v))
    s = jnp.einsum('bhrnqd,bhrnkd->bhrnqk', qb, k2) * (hd ** -0.5)
    qpos = jnp.arange(nb)[:, None] * L + jnp.arange(L)[None, :]
    kpos = jnp.arange(nb)[:, None] * L - L + jnp.arange(2 * L)[None, :]
    dist = qpos[:, :, None] - kpos[:, None, :]
    mask = (dist >= 0) & (dist <= L) & (kpos[:, None, :] >= 0)
    s = jnp.where(mask, s, -jnp.inf)
    m = jnp.max(s, axis=-1, keepdims=True)
    p = jnp.exp(s - m)
    den = jnp.sum(p, axis=-1, keepdims=True)
    o = jnp.einsum('bhrnqk,bhrnkd->bhrnqd', p, v2) / den

    def from_blocks(t):
        c = t.shape[-1]
        t = t.reshape(B, H, dilation, nb * L, c)[:, :, :, :Sr]
        return t.transpose(0, 1, 3, 2, 4).reshape(B, H, S, c)

    return from_blocks(o), from_blocks(m), from_blocks(den)


def _dilated_attention(q, k, v):
    outs, maxes, dens = [], [], []
    for window, dilation in DILATED_PATTERNS:
        o, m, d = _dilated_pattern(q, k, v, window, dilation)
        outs.append(o)
        maxes.append(m)
        dens.append(d)
    m_all = functools_max(maxes)
    weights = [d * jnp.exp(m - m_all) for d, m in zip(dens, maxes)]
    num = sum(w * o for w, o in zip(weights, outs))
    return num / sum(weights)


def functools_max(arrs):
    out = arrs[0]
    for a in arrs[1:]:
        out = jnp.maximum(out, a)
    return out


def _retention(q, k, v, log_gamma):
    B, H, S, dk = q.shape
    dv = v.shape[-1]
    C = min(RET_CHUNK, S)
    nc = S // C
    qc = q.reshape(B, H, nc, C, dk)
    kc = k.reshape(B, H, nc, C, dk)
    vc = v.reshape(B, H, nc, C, dv)
    idx = jnp.arange(C, dtype=jnp.float32)
    diff = idx[:, None] - idx[None, :]
    lg = log_gamma[:, None, None]
    decay = jnp.where(diff >= 0, jnp.exp(lg * jnp.maximum(diff, 0.0)), 0.0)
    zeta = jnp.exp(log_gamma[:, None] * (C - 1 - idx))
    xi = jnp.exp(log_gamma[:, None] * (idx + 1))
    gamma_c = jnp.exp(log_gamma * C)
    inner = jnp.einsum('bhnik,bhnjk->bhnij', qc, kc) * decay[None, :, None]
    y = jnp.einsum('bhnij,bhnjv->bhniv', inner, vc)
    kv = jnp.einsum('bhnjk,bhnjv->bhnkv', kc * zeta[None, :, None, :, None], vc)

    def step(state, kv_n):
        return state * gamma_c[None, :, None, None] + kv_n, state

    init = jnp.zeros((B, H, dk, dv), dtype=kv.dtype)
    _, prev = lax.scan(step, init, jnp.moveaxis(kv, 2, 0))
    prev = jnp.moveaxis(prev, 0, 2)
    y = y + jnp.einsum('bhnik,bhnkv->bhniv', qc * xi[None, :, None, :, None], prev)
    return y.reshape(B, H, S, dv)


def _mixer(xn, w_in, b_gate, g_q, g_k, w_att, g_ret, w_ret, w_out):
    dt = xn.dtype
    f32 = jnp.float32
    B, S, _ = xn.shape
    qa, ka, va, qr, kr, vr, gr, ga, gb = jnp.split(xn @ w_in, _split_points(), axis=-1)
    pos = jnp.arange(S, dtype=f32)
    inv_a = ROPE_THETA ** (-jnp.arange(0, ATT_HEAD_DIM, 2, dtype=f32) / ATT_HEAD_DIM)
    q = _rotate(_rmsnorm(_heads(qa, ATT_HEADS, ATT_HEAD_DIM).astype(f32), g_q), pos, inv_a)
    k = _rotate(_rmsnorm(_heads(ka, ATT_HEADS, ATT_HEAD_DIM).astype(f32), g_k), pos, inv_a)
    v = _heads(va, ATT_HEADS, ATT_HEAD_DIM).astype(f32)
    y_att = _merge_heads(_dilated_attention(q, k, v)).astype(dt) @ w_att
    inv_r = 1.0 / (ROPE_THETA ** jnp.linspace(0.0, 1.0, RET_QK_DIM // 2, dtype=f32))
    q = _rotate(_heads(qr, RET_HEADS, RET_QK_DIM).astype(f32), pos, inv_r)
    k = _rotate(_heads(kr, RET_HEADS, RET_QK_DIM).astype(f32), pos, inv_r) * (RET_QK_DIM ** -0.5)
    v = _heads(vr, RET_HEADS, RET_V_DIM).astype(f32)
    log_gamma = jnp.log(1.0 - jnp.exp2(-5.0 - jnp.arange(RET_HEADS, dtype=f32)))
    y = _rmsnorm(_retention(q, k, v, log_gamma), g_ret[:, None, :])
    y_ret = (_merge_heads(y).astype(dt) * jax.nn.silu(gr)) @ w_ret
    gate_a = jax.nn.sigmoid(ga + b_gate[:D_MODEL])
    gate_b = jax.nn.sigmoid(gb + b_gate[D_MODEL:])
    return (gate_a * y_att + gate_b * y_ret) @ w_out


def _hmoe(xn, w_rg, b_rg, w_re, b_re, w1, w3, w2):
    B, S, D = xn.shape
    t = xn.reshape(B * S, D)
    T = t.shape[0]
    group_logits = (t @ w_rg + b_rg).astype(jnp.float32)
    group_prob = jax.nn.softmax(group_logits, axis=-1)
    g_sel = jnp.argmax(group_logits, axis=-1)
    p_group = jnp.take_along_axis(group_prob, g_sel[:, None], axis=-1)
    exp_logits = (t @ w_re + b_re).astype(jnp.float32).reshape(T, N_GROUPS, EXPERTS_PER_GROUP)
    in_group = jnp.take_along_axis(exp_logits, g_sel[:, None, None], axis=1)[:, 0]
    top_v, top_i = lax.top_k(in_group, TOP_K_IN_GROUP)
    top_w = jax.nn.softmax(top_v, axis=-1) * p_group
    expert_id = g_sel[:, None] * EXPERTS_PER_GROUP + top_i
    gate = jnp.sum(jax.nn.one_hot(expert_id, N_EXPERTS, dtype=jnp.float32) * top_w[..., None], axis=1)
    gate = gate.astype(t.dtype)
    y = jnp.zeros_like(t)
    for e in range(N_EXPERTS):
        h = jax.nn.silu(t @ w1[e]) * (t @ w3[e])
        y = y + gate[:, e:e + 1] * (h @ w2[e])
    return y.reshape(B, S, D)


def setup_inputs(seed: int = 0) -> dict:
    key = jax.random.key(seed)
    ks = jax.random.split(key, 20)
    f32 = jnp.float32

    def nrm(k, shape, scale):
        return jax.random.normal(k, shape, f32) * scale

    return {
        'x': nrm(ks[0], (BATCH, SEQ, D_MODEL), 1.0),
        'g_norm_mix': 1.0 + nrm(ks[1], (DEPTH, D_MODEL), 0.02),
        'w_in': nrm(ks[2], (DEPTH, D_MODEL, IN_WIDTH), D_MODEL ** -0.5),
        'b_merge_gate': nrm(ks[3], (DEPTH, 2 * D_MODEL), 0.02),
        'g_q': 1.0 + nrm(ks[4], (DEPTH, ATT_HEAD_DIM), 0.02),
        'g_k': 1.0 + nrm(ks[5], (DEPTH, ATT_HEAD_DIM), 0.02),
        'w_branch_att': nrm(ks[6], (DEPTH, ATT_W, D_MODEL), ATT_W ** -0.5),
        'g_ret_norm': 1.0 + nrm(ks[7], (DEPTH, RET_HEADS, RET_V_DIM), 0.02),
        'w_branch_ret': nrm(ks[8], (DEPTH, RET_V_W, D_MODEL), RET_V_W ** -0.5),
        'w_out': nrm(ks[9], (DEPTH, D_MODEL, D_MODEL), D_MODEL ** -0.5),
        'g_norm_ffn': 1.0 + nrm(ks[10], (DEPTH, D_MODEL), 0.02),
        'w_router_group': nrm(ks[11], (DEPTH, D_MODEL, N_GROUPS), D_MODEL ** -0.5),
        'b_router_group': nrm(ks[12], (DEPTH, N_GROUPS), 0.01),
        'w_router_expert': nrm(ks[13], (DEPTH, D_MODEL, N_EXPERTS), D_MODEL ** -0.5),
        'b_router_expert': nrm(ks[14], (DEPTH, N_EXPERTS), 0.01),
        'w1': nrm(ks[15], (DEPTH, N_EXPERTS, D_MODEL, EXPERT_FF), D_MODEL ** -0.5),
        'w3': nrm(ks[16], (DEPTH, N_EXPERTS, D_MODEL, EXPERT_FF), D_MODEL ** -0.5),
        'w2': nrm(ks[17], (DEPTH, N_EXPERTS, EXPERT_FF, D_MODEL), EXPERT_FF ** -0.5),
    }


def reference(x, g_norm_mix, w_in, b_merge_gate, g_q, g_k, w_branch_att, g_ret_norm,
              w_branch_ret, w_out, g_norm_ffn, w_router_group, b_router_group,
              w_router_expert, b_router_expert, w1, w3, w2):
    for l in range(DEPTH):
        x = x + _mixer(_rmsnorm(x, g_norm_mix[l]), w_in[l], b_merge_gate[l], g_q[l], g_k[l],
                       w_branch_att[l], g_ret_norm[l], w_branch_ret[l], w_out[l])
        x = x + _hmoe(_rmsnorm(x, g_norm_ffn[l]), w_router_group[l], b_router_group[l],
                      w_router_expert[l], b_router_expert[l], w1[l], w3[l], w2[l])
    return x
```

```cpp
#include <hip/hip_runtime.h>
#include <cstdio>
#include <cstdint>

#define GAS __attribute__((address_space(1)))
#define LAS __attribute__((address_space(3)))
typedef unsigned short bf16;
typedef unsigned v4u __attribute__((ext_vector_type(4)));
typedef unsigned v2u __attribute__((ext_vector_type(2)));
typedef float f32x4 __attribute__((ext_vector_type(4)));
typedef float f32x2 __attribute__((ext_vector_type(2)));
typedef short bf16x8 __attribute__((ext_vector_type(8)));
typedef GAS unsigned gu32;
#define RLX_AGENT __ATOMIC_RELAXED, __HIP_MEMORY_SCOPE_AGENT
#define LDS_WAIT() asm volatile("s_waitcnt lgkmcnt(0)" ::: "memory")
#define VM_WAIT() asm volatile("s_waitcnt vmcnt(0)" ::: "memory")

__device__ __forceinline__ unsigned pk2(float lo, float hi) { unsigned r; asm volatile("v_cvt_pk_bf16_f32 %0, %1, %2" : "=v"(r) : "v"(lo), "v"(hi)); return r; }
__device__ __forceinline__ unsigned f2bf(float f) { return pk2(f, 0.f) & 0xffffu; }
__device__ __forceinline__ float bf2f(unsigned short h) { return __builtin_bit_cast(float, (unsigned)h << 16); }
__device__ __forceinline__ float bflo(unsigned w) { return __builtin_bit_cast(float, w << 16); }
__device__ __forceinline__ float bfhi(unsigned w) { return __builtin_bit_cast(float, w & 0xffff0000u); }
__device__ __forceinline__ float wave_sum(float v) {
#define WS_DPP(ctrl) v += __builtin_bit_cast(float, __builtin_amdgcn_update_dpp(0, __builtin_bit_cast(int, v), ctrl, 0xf, 0xf, false))
    WS_DPP(0xB1); WS_DPP(0x4E); WS_DPP(0x141); WS_DPP(0x140);
#undef WS_DPP
    const int iv = __builtin_bit_cast(int, v);
    return (__builtin_bit_cast(float, __builtin_amdgcn_readlane(iv, 0)) + __builtin_bit_cast(float, __builtin_amdgcn_readlane(iv, 16))) + (__builtin_bit_cast(float, __builtin_amdgcn_readlane(iv, 32)) + __builtin_bit_cast(float, __builtin_amdgcn_readlane(iv, 48)));
}

constexpr int NB = 8, SEQ = 2048, D = 1024, M = NB * SEQ;
constexpr int AH = 16, AHD = 64;
constexpr int RH = 4, RDK = 256, RDV = 512, RCH = 128;
constexpr int NIN = 11264;
constexpr int NG = 4, EPG = 8, NE = 32, FF = 256;
constexpr float EPS = 1e-6f;
constexpr float C2 = 0.125f * 1.4426950408889634f;

constexpr size_t MiB = 1u << 20;
constexpr size_t WS_CTL = 0, CTL_ZERO_BYTES = 256 * 1024;
constexpr size_t WS_SS = 512 * 1024;
constexpr size_t WS_COSA = 1 * MiB, WS_SINA = WS_COSA + 256 * 1024, WS_COSR = WS_SINA + 256 * 1024, WS_SINR = WS_COSR + 1 * MiB;
constexpr size_t WS_WIN = 4 * MiB;
constexpr size_t WS_WMIX = 26 * MiB;
constexpr size_t WS_WOUT = 32 * MiB;
constexpr size_t WS_XN = 34 * MiB;
constexpr size_t WS_QA = 66 * MiB;
constexpr size_t WS_KA = 98 * MiB, WS_VA = 130 * MiB;
constexpr size_t WS_QR = 98 * MiB, WS_KR = 130 * MiB;
constexpr size_t WS_V01 = 162 * MiB, WS_V23 = 194 * MiB;
constexpr size_t WS_M32 = 98 * MiB;
constexpr size_t WS_MRG = 34 * MiB;
constexpr size_t WS_TMP = 226 * MiB;
constexpr size_t WS_X1N = 34 * MiB;
constexpr size_t WS_W13 = 66 * MiB;
constexpr size_t WS_W2 = 130 * MiB;
constexpr size_t WS_H = 146 * MiB;
constexpr int HROWS = 49152;
constexpr size_t WS_LIST = 170 * MiB;
constexpr size_t WS_GATE = 174 * MiB;
constexpr size_t WS_PTOK = 178 * MiB;
constexpr size_t WS_PLO = 186 * MiB;
constexpr size_t WS_PHI = 194 * MiB;
constexpr size_t WS_END = 242 * MiB;
constexpr int CW_BAR = 4096;
constexpr int CW_CNT = 16384;
constexpr int CW_PCNT = CW_CNT + 64 * 64;
constexpr int CW_UPC = CW_PCNT + 64 * 112;
constexpr int CW_W2D = CW_UPC + 64 * 64;
static_assert((CW_W2D + 128) * 4 <= (int)CTL_ZERO_BYTES, "ctl");

constexpr int RING_OFF = 0, RING_BYTES = 131072;
constexpr int LDSCTL_OFF = 148480, MISC_OFF = LDSCTL_OFF + 320;
constexpr int LDS_TP_OFF = MISC_OFF + 128;
constexpr int LDS_PTP_OFF = 150016;
constexpr int LDS_BYTES = 155648;
static_assert(LDS_TP_OFF + 66 * 4 <= LDS_BYTES, "LDS map");
constexpr int NWAVES = 8;
#define MK_MODE 1
#define ATT_SIMPLE 0
#define RET_SIMPLE 0
#ifndef RET_SIMPLE
#define RET_SIMPLE 1
#endif
#ifndef ATT_SIMPLE
#define ATT_SIMPLE 1
#endif
namespace pg8 {
#define PG8_LAS __attribute__((address_space(3)))
typedef unsigned short bf16_t;
typedef short bf16x8 __attribute__((ext_vector_type(8)));
typedef float f32x4 __attribute__((ext_vector_type(4)));
typedef unsigned u32x4 __attribute__((ext_vector_type(4)));
constexpr int BM = 256, BK = 64, HALF = 128, HTB = HALF * BK * 2  , STAGE_BYTES = 8 * HTB, NXCD = 8, WGM = 8;

__host__ __device__ __forceinline__ int lds_byte(int r, int c) { const int st = (r >> 4) * 2 + (c >> 5), rr = r & 15, cc = c & 31, ob = rr * 64 + cc * 2; return st * 1024 + (ob ^ (((ob >> 9) & 1) << 5)); }
__host__ __device__ __forceinline__ void stage_rc(int b, int& R, int& C) { const int st = b / 1024, sb = b % 1024, swz = sb ^ (((sb >> 9) & 1) << 5); R = (st >> 1) * 16 + swz / 64; C = (st & 1) * 32 + (swz % 64) / 2; }
__host__ __device__ __forceinline__ int perm32(int rho) { const int n = rho >> 4, i = rho & 15; return 8 * (i >> 2) + 4 * n + (i & 3); }

struct Unit { const char* A; const char* B; const int* rows; int nt; int pm, pn, part, aux; bool fin; };

struct TileOrder {
    int nM, nN, nwg, G, c;
    __device__ void init(int M, int N, int G_, int c_) { nM = M / BM; nN = N / BM; nwg = nM * nN; G = G_; c = c_; }
    __device__ __forceinline__ bool tile(int i, int& pm, int& pn) const {
        const long L = (long)i * G + c; if (L >= nwg) return false;
        int wgid = (int)L; { const int q = nwg / NXCD, r = nwg % NXCD, xcd = wgid % NXCD, off = wgid / NXCD; wgid = (xcd < r ? xcd * (q + 1) : r * (q + 1) + (xcd - r) * q) + off; }
        const int nig = WGM * nN, gid = wgid / nig, fm = gid * WGM, gsz = (nM - fm) < WGM ? (nM - fm) : WGM;
        pm = fm + ((wgid % nig) % gsz); pn = (wgid % nig) / gsz; return true;
    }
};

__device__ __forceinline__ unsigned cvt_pk_bf16(float lo, float hi) { unsigned r; asm volatile("v_cvt_pk_bf16_f32 %0, %1, %2" : "=v"(r) : "v"(lo), "v"(hi)); return r; }

template <class Epi, class Sched, bool GATHER, bool ALIGN_EPI = true>
__device__ __forceinline__ void gemm_phase(PG8_LAS unsigned char* lds, const int lda, const int ldb, const Sched& S, const Epi& E) {
    const int tid = threadIdx.x, wid = __builtin_amdgcn_readfirstlane(tid >> 6), lane = tid & 63, wr = wid >> 2, wc = wid & 3, fr = lane & 15, fq = lane >> 4;
    unsigned voffA[GATHER ? 2 : 1][2], voffB[2]; int RA[2], CA[2];
#pragma unroll
    for (int i = 0; i < 2; ++i) { int R, C; stage_rc(tid * 16 + i * 8192, R, C); const int Rb = Epi::PERM ? ((R & ~31) + perm32(R & 31)) : R;
        RA[i] = R; CA[i] = C;
        voffA[0][i] = (unsigned)(R * lda + C) * 2u; voffB[i] = (unsigned)(Rb * ldb + C) * 2u; }
    const size_t kstep = (size_t)(BK * 2);
    const size_t hstepB = (size_t)HALF * ldb * 2;
    const size_t hstepA = GATHER ? (size_t)0 : (size_t)HALF * lda * 2;
    const unsigned ldsw = (unsigned)wid * 1024u;
    const int aoff = lds_byte(wr * 64 + fr, fq * 8), boff = lds_byte(wc * 32 + fr, fq * 8);
#define PG8_SA(b, h) (((b) * 2 + (h)) * HTB)
#define PG8_SB(b, h) ((4 + (b) * 2 + (h)) * HTB)
#define PG8_STAGE(bufoff, gbase, voff) do { _Pragma("unroll") for (int _i = 0; _i < 2; ++_i) \
        __builtin_amdgcn_global_load_lds((const unsigned*)((const char*)(gbase) + (voff)[_i]), (PG8_LAS unsigned*)(lds + (bufoff) + ldsw + _i * 8192), 16, 0, 0); } while (0)
#define PG8_LDA(dst, b, h) do { _Pragma("unroll") for (int m = 0; m < 4; ++m) _Pragma("unroll") for (int k = 0; k < 2; ++k) dst[m][k] = *(const PG8_LAS bf16x8*)(lds + PG8_SA(b, h) + aoff + m * 2048 + k * 1024); } while (0)
#define PG8_LDB(dst, b, h) do { _Pragma("unroll") for (int n = 0; n < 2; ++n) _Pragma("unroll") for (int k = 0; k < 2; ++k) dst[n][k] = *(const PG8_LAS bf16x8*)(lds + PG8_SB(b, h) + boff + n * 2048 + k * 1024); } while (0)
#define PG8_MMA(ai, bj, At, Bt) do { __builtin_amdgcn_s_setprio(1); _Pragma("unroll") for (int m = 0; m < 4; ++m) _Pragma("unroll") for (int n = 0; n < 2; ++n) _Pragma("unroll") for (int k = 0; k < 2; ++k) \
        acc[ai][bj][m][n] = __builtin_amdgcn_mfma_f32_16x16x32_bf16(Bt[n][k], At[m][k], acc[ai][bj][m][n], 0, 0, 0); __builtin_amdgcn_s_setprio(0); } while (0)
#define PG8_WAIT_V(n) asm volatile("s_waitcnt vmcnt(" #n ")" ::: "memory")
#define PG8_WAIT_L(n) asm volatile("s_waitcnt lgkmcnt(" #n ")" ::: "memory")
#define PG8_BAR __builtin_amdgcn_s_barrier()
#define PG8_SCHED __builtin_amdgcn_sched_barrier(0)
#define PG8_GATHER_OFFS(U, dst) do { if constexpr (GATHER) { _Pragma("unroll") for (int _h = 0; _h < 2; ++_h) _Pragma("unroll") for (int _i = 0; _i < 2; ++_i) \
        dst[_h][_i] = (unsigned)(S.rowof((U).rows[_h * HALF + RA[_i]]) * lda + CA[_i]) * 2u; } } while (0)
    Unit cur, nxt; int ui = 0;
    if (!S.next(0, cur)) return;
    f32x4 acc[2][2][4][2];
#pragma unroll
    for (int a = 0; a < 2; ++a)
#pragma unroll
        for (int b = 0; b < 2; ++b)
#pragma unroll
            for (int m = 0; m < 4; ++m)
#pragma unroll
                for (int n = 0; n < 2; ++n) acc[a][b][m][n] = (f32x4){0.f, 0.f, 0.f, 0.f};
    bf16x8 At[4][2], B0[2][2], B1[2][2];
    const char* cA = cur.A; const char* cB = cur.B;
    PG8_GATHER_OFFS(cur, voffA);
    PG8_STAGE(PG8_SB(0, 0), cB, voffB); PG8_STAGE(PG8_SB(0, 1), cB + hstepB, voffB); PG8_STAGE(PG8_SA(0, 0), cA, voffA[0]); PG8_STAGE(PG8_SA(0, 1), cA + hstepA, voffA[GATHER ? 1 : 0]);
    if (wr == 1) PG8_BAR;
    PG8_WAIT_V(2); PG8_BAR;
    PG8_STAGE(PG8_SB(1, 0), cB + kstep, voffB); PG8_STAGE(PG8_SA(1, 0), cA + kstep, voffA[0]); PG8_STAGE(PG8_SB(1, 1), cB + hstepB + kstep, voffB);
    PG8_WAIT_V(6); PG8_BAR;
    for (;;) {
        const bool has_next = S.next(ui + 1, nxt);
        const char* nA = has_next ? nxt.A : cA; const char* nB = has_next ? nxt.B : cB;
        const int nt = cur.nt;
        for (int t = 0; t < nt; t += 2) {
            const bool last = (t == nt - 2);
            const char* a1 = cA + (size_t)(t + 1) * kstep;
            const char* a2 = last ? nA : cA + (size_t)(t + 2) * kstep; const char* b2 = last ? nB : cB + (size_t)(t + 2) * kstep;
            const char* a3 = a2 + kstep; const char* b3 = b2 + kstep;
            PG8_LDB(B0, 0, 0); PG8_LDB(B1, 0, 1); PG8_SCHED; PG8_LDA(At, 0, 0); PG8_STAGE(PG8_SA(1, 1), a1 + hstepA, voffA[GATHER ? 1 : 0]);
            if constexpr (GATHER) { if (last && has_next) { PG8_GATHER_OFFS(nxt, voffA); } }
            PG8_WAIT_V(8); PG8_WAIT_L(0); PG8_BAR; PG8_MMA(0, 0, At, B0); PG8_MMA(0, 1, At, B1); PG8_BAR; PG8_SCHED;
            PG8_LDA(At, 0, 1); PG8_STAGE(PG8_SB(0, 0), b2, voffB); PG8_STAGE(PG8_SB(0, 1), b2 + hstepB, voffB); PG8_STAGE(PG8_SA(0, 0), a2, voffA[0]);
            PG8_WAIT_V(8); PG8_WAIT_L(0); PG8_BAR; PG8_MMA(1, 0, At, B0); PG8_MMA(1, 1, At, B1); PG8_BAR; PG8_SCHED;
            PG8_LDB(B0, 1, 0); PG8_LDB(B1, 1, 1); PG8_SCHED; PG8_LDA(At, 1, 0); PG8_STAGE(PG8_SA(0, 1), a2 + hstepA, voffA[GATHER ? 1 : 0]);
            PG8_WAIT_V(8); PG8_WAIT_L(0); PG8_BAR; PG8_MMA(0, 0, At, B0); PG8_MMA(0, 1, At, B1); PG8_BAR; PG8_SCHED;
            PG8_LDA(At, 1, 1); PG8_STAGE(PG8_SB(1, 0), b3, voffB); PG8_STAGE(PG8_SB(1, 1), b3 + hstepB, voffB); PG8_STAGE(PG8_SA(1, 0), a3, voffA[0]);
            PG8_WAIT_V(8); PG8_WAIT_L(0); PG8_BAR; PG8_MMA(1, 0, At, B0); PG8_MMA(1, 1, At, B1); PG8_BAR; PG8_SCHED;
        }
        if constexpr (ALIGN_EPI) { if (wr == 0) PG8_BAR; }
        if (cur.fin) {
            E(acc, cur, wr, wc, fr, fq);
            if constexpr (Epi::SIGNAL) {
                static_assert(ALIGN_EPI, "the signal barrier needs both wave halves aligned");
                asm volatile("s_waitcnt vmcnt(0)" ::: "memory"); PG8_BAR; if (tid == 0) E.signal(cur); }
#pragma unroll
            for (int a = 0; a < 2; ++a)
#pragma unroll
                for (int b = 0; b < 2; ++b)
#pragma unroll
                    for (int m = 0; m < 4; ++m)
#pragma unroll
                        for (int n = 0; n < 2; ++n) acc[a][b][m][n] = (f32x4){0.f, 0.f, 0.f, 0.f};
        }
        if (!has_next) break;
        cur = nxt; cA = nA; cB = nB; ++ui;
        if constexpr (ALIGN_EPI) { if (wr == 1) PG8_BAR; }
    }
    PG8_WAIT_V(0);
    if constexpr (!ALIGN_EPI) { if (wr == 0) PG8_BAR; }
    PG8_BAR;
#undef PG8_SA
#undef PG8_SB
#undef PG8_STAGE
#undef PG8_LDA
#undef PG8_LDB
#undef PG8_MMA
#undef PG8_WAIT_V
#undef PG8_WAIT_L
#undef PG8_BAR
#undef PG8_SCHED
#undef PG8_GATHER_OFFS
}
}
#define XB_TMO      128
#define XB_XCNT(j)  (256  + 64 * (j))
#define XB_XSUB(j)  (1280 + 64 * (j))
#define XB_XGEN(j)  (2304 + 64 * (j))
#define XB_TOP      3328
#define XB_TOPGEN   3392
#define XCD_BAR_WORDS 3456
#define XB_SPIN_CAP (1u << 18)

__device__ __forceinline__ unsigned xb_ld(unsigned* p)              { return __hip_atomic_load(p, __ATOMIC_RELAXED, __HIP_MEMORY_SCOPE_AGENT); }
__device__ __forceinline__ unsigned xb_add(unsigned* p, unsigned v) { return __hip_atomic_fetch_add(p, v, __ATOMIC_RELAXED, __HIP_MEMORY_SCOPE_AGENT); }
__device__ __forceinline__ unsigned xb_xcc_id() { return (unsigned)__builtin_amdgcn_s_getreg((3 << 11) | 20) & 0xFu; }
#define XB_SPIN(cond, bar) do { unsigned _sp = 0; while (cond) { __builtin_amdgcn_s_sleep(1); \
    if ((++_sp & 255u) == 0u) { if (xb_ld(&(bar)[XB_TMO])) break; if (_sp > XB_SPIN_CAP) { atomicAdd(&(bar)[XB_TMO], 1u); break; } } } } while (0)

struct XcdBarrier { unsigned* bar; unsigned x; volatile LAS unsigned* st; };

__device__ __forceinline__ XcdBarrier xcd_barrier_post(unsigned* bar, volatile LAS unsigned* st) {
    XcdBarrier b; b.bar = bar; b.x = xb_xcc_id(); b.st = st;
    if (threadIdx.x == 0) (void)xb_add(&bar[XB_XCNT(b.x)], 1u);
    return b;
}
__device__ __forceinline__ void xcd_barrier_complete(unsigned* bar, unsigned x, unsigned& nloc, unsigned& nx) {
    const unsigned G = gridDim.x * gridDim.y * gridDim.z;
    unsigned sum, cnt, mine, sp = 0u;
    for (;;) {
        sum = 0u; cnt = 0u; mine = 0u;
#pragma unroll
        for (unsigned j = 0; j < 16; ++j) { const unsigned c = xb_ld(&bar[XB_XCNT(j)]); sum += c; cnt += (c > 0u) ? 1u : 0u; mine = (j == x) ? c : mine; }
        if (sum == G) break;
        __builtin_amdgcn_s_sleep(1);
        if ((++sp & 255u) == 0u) { if (xb_ld(&bar[XB_TMO])) break; if (sp > XB_SPIN_CAP) { atomicAdd(&bar[XB_TMO], 1u); break; } }
    }
    nloc = mine > 0u ? mine : 1u; nx = cnt > 0u ? cnt : 1u;
}
__device__ __forceinline__ void xcd_barrier(const XcdBarrier& b) {
    asm volatile("s_waitcnt vmcnt(0)" ::: "memory");
    __syncthreads();
    if (threadIdx.x == 0) {
        unsigned* bar = b.bar;
        __builtin_amdgcn_s_waitcnt(0);
        unsigned nloc = b.st[0], nx = b.st[1];
        if (nloc == 0u) { xcd_barrier_complete(bar, b.x, nloc, nx); b.st[0] = nloc; b.st[1] = nx; }
        const unsigned old = xb_add(&bar[XB_XSUB(b.x)], 1u);
        const unsigned gen = old / nloc;
        if (old + 1u == (gen + 1u) * nloc) {
            __builtin_amdgcn_fence(__ATOMIC_RELEASE, "agent");
            asm volatile("s_waitcnt vmcnt(0)" ::: "memory");
            const unsigned og = xb_add(&bar[XB_TOP], 1u);
            const unsigned tg = og / nx;
            if (og + 1u == (tg + 1u) * nx) xb_add(&bar[XB_TOPGEN], 1u);
            else XB_SPIN(xb_ld(&bar[XB_TOPGEN]) == tg, bar);
            __builtin_amdgcn_fence(__ATOMIC_ACQUIRE, "agent");
            xb_add(&bar[XB_XGEN(b.x)], 1u);
            asm volatile("s_waitcnt vmcnt(0)" ::: "memory");
        } else {
            XB_SPIN(xb_ld(&bar[XB_XGEN(b.x)]) == gen, bar);
            __builtin_amdgcn_fence(__ATOMIC_ACQUIRE, "agent");
            asm volatile("s_waitcnt vmcnt(0)" ::: "memory");
        }
    }
    __syncthreads();
}

struct Frame {
    LAS unsigned char* lds;
    volatile LAS unsigned* MISC;
    unsigned* ctl;
    unsigned char* ws;
    int tid, lane, wave;
    int vcu, G;
    const float* const* in;
    float* out;
};

template <bool WT = false>
__device__ __forceinline__ void transpose_item(const float* W, int N, int k0, int lc0, bf16* WT_, int ldt, int pr0, int koff, LAS float* scr, int lane) {
    {
        f32x4 t[8]; const int rr = lane >> 3, cc = 4 * (lane & 7);
#pragma unroll
        for (int i = 0; i < 8; ++i) t[i] = *(const f32x4*)(W + (size_t)(k0 + 8 * i + rr) * N + lc0 + cc);
#pragma unroll
        for (int i = 0; i < 8; ++i) { LAS float* d = scr + (8 * i + rr) * 33 + cc; d[0] = t[i][0]; d[1] = t[i][1]; d[2] = t[i][2]; d[3] = t[i][3]; }
    }
    LDS_WAIT(); asm volatile("" ::: "memory");
    const int c = lane & 7;
#pragma unroll
    for (int j = 0; j < 4; ++j) { const int n = (lane >> 3) + 8 * j; const LAS float* s = scr + (8 * c) * 33 + n;
        v4u o; o.x = pk2(s[0 * 33], s[1 * 33]); o.y = pk2(s[2 * 33], s[3 * 33]); o.z = pk2(s[4 * 33], s[5 * 33]); o.w = pk2(s[6 * 33], s[7 * 33]);
        if constexpr (WT) { void* p_ = (void*)(WT_ + (size_t)(pr0 + n) * ldt + koff + k0 + 8 * c); asm volatile("global_store_dwordx4 %0, %1, off sc1\n\ts_nop 1" :: "v"(p_), "v"(o) : "memory"); }
        else *(GAS v4u*)(WT_ + (size_t)(pr0 + n) * ldt + koff + k0 + 8 * c) = o; }
    LDS_WAIT(); asm volatile("" ::: "memory");
}
__device__ __forceinline__ void rms_row_to_bf16(const float* xrow, const float* g, bf16* orow, int lane) {
    const GAS f32x4* xr = (const GAS f32x4*)xrow + lane; const GAS f32x4* gr = (const GAS f32x4*)g + lane;
    f32x4 v[4]; float s = 0.f;
#pragma unroll
    for (int j = 0; j < 4; ++j) { v[j] = xr[64 * j]; s += (v[j].x * v[j].x + v[j].y * v[j].y) + (v[j].z * v[j].z + v[j].w * v[j].w); }
    const float rinv = 1.f / sqrtf(wave_sum(s) * (1.f / D) + EPS);
    GAS unsigned long long* o8 = (GAS unsigned long long*)orow + lane;
#pragma unroll
    for (int j = 0; j < 4; ++j) { const f32x4 gg = gr[64 * j];
        o8[64 * j] = (unsigned long long)pk2(v[j].x * rinv * gg.x, v[j].y * rinv * gg.y) | ((unsigned long long)pk2(v[j].z * rinv * gg.z, v[j].w * rinv * gg.w) << 32); }
}
__device__ __forceinline__ int win_logical(int p) {
    if (p >= 2048) return p;
    const int t = p >> 8, q = p & 255, bj = q >> 7, wc = (q >> 5) & 3, j = q & 31;
    return t * 256 + 64 * wc + 32 * bj + j;
}
__device__ __forceinline__ void p0_prologue(Frame& F) {
    LAS float* scr = (LAS float*)(F.lds + RING_OFF + F.wave * 16384);
    const int gw = F.vcu * NWAVES + F.wave, NGW = F.G * NWAVES;
    bf16* WinT = (bf16*)(F.ws + WS_WIN); bf16* WmixT = (bf16*)(F.ws + WS_WMIX); bf16* WoutT = (bf16*)(F.ws + WS_WOUT);
    constexpr int I_IN = (D / 64) * (NIN / 32), I_ATT = (D / 64) * (D / 32), I_RET = (2048 / 64) * (D / 32), I_OUT = (D / 64) * (D / 32);
    constexpr int NITEMS = I_IN + I_ATT + I_RET + I_OUT;
    for (int it = gw; it < NITEMS; it += NGW) {
        int r = it;
        if (r < I_IN) { const int nblk = NIN / 32, kb = r / nblk, nb = r % nblk; transpose_item(F.in[2], NIN, 64 * kb, win_logical(32 * nb), WinT, D, 32 * nb, 0, scr, F.lane); continue; } r -= I_IN;
        if (r < I_ATT) { const int nblk = D / 32, kb = r / nblk, nb = r % nblk; transpose_item(F.in[6], D, 64 * kb, 32 * nb, WmixT, 3072, 32 * nb, 0, scr, F.lane); continue; } r -= I_ATT;
        if (r < I_RET) { const int nblk = D / 32, kb = r / nblk, nb = r % nblk; transpose_item(F.in[8], D, 64 * kb, 32 * nb, WmixT, 3072, 32 * nb, 1024, scr, F.lane); continue; } r -= I_RET;
        { const int nblk = D / 32, kb = r / nblk, nb = r % nblk; transpose_item(F.in[9], D, 64 * kb, 32 * nb, WoutT, D, 32 * nb, 0, scr, F.lane); }
    }
    bf16* XN = (bf16*)(F.ws + WS_XN);
    for (int m = gw; m < M; m += 2 * NGW) {
        const int m2 = m + NGW;
        const GAS f32x4* xa = (const GAS f32x4*)(F.in[0] + (size_t)m * D) + F.lane; const GAS f32x4* xb = (const GAS f32x4*)(F.in[0] + (size_t)(m2 < M ? m2 : m) * D) + F.lane;
        const GAS f32x4* gr = (const GAS f32x4*)F.in[1] + F.lane;
        f32x4 va[4], vb[4]; float sa = 0.f, sb = 0.f;
#pragma unroll
        for (int j = 0; j < 4; ++j) { va[j] = xa[64 * j]; vb[j] = xb[64 * j]; }
#pragma unroll
        for (int j = 0; j < 4; ++j) { sa += (va[j].x * va[j].x + va[j].y * va[j].y) + (va[j].z * va[j].z + va[j].w * va[j].w); sb += (vb[j].x * vb[j].x + vb[j].y * vb[j].y) + (vb[j].z * vb[j].z + vb[j].w * vb[j].w); }
        const float ra = 1.f / sqrtf(wave_sum(sa) * (1.f / D) + EPS), rb = 1.f / sqrtf(wave_sum(sb) * (1.f / D) + EPS);
        GAS unsigned long long* oa = (GAS unsigned long long*)(XN + (size_t)m * D) + F.lane; GAS unsigned long long* ob = (GAS unsigned long long*)(XN + (size_t)(m2 < M ? m2 : m) * D) + F.lane;
#pragma unroll
        for (int j = 0; j < 4; ++j) { const f32x4 gg = gr[64 * j];
            oa[64 * j] = (unsigned long long)pk2(va[j].x * ra * gg.x, va[j].y * ra * gg.y) | ((unsigned long long)pk2(va[j].z * ra * gg.z, va[j].w * ra * gg.w) << 32);
            if (m2 < M) ob[64 * j] = (unsigned long long)pk2(vb[j].x * rb * gg.x, vb[j].y * rb * gg.y) | ((unsigned long long)pk2(vb[j].z * rb * gg.z, vb[j].w * rb * gg.w) << 32); }
    }
    const int gt = (F.vcu * NWAVES + F.wave) * 64 + F.lane, NGT = F.G * NWAVES * 64;
    float* cosa = (float*)(F.ws + WS_COSA); float* sina = (float*)(F.ws + WS_SINA); float* cosr = (float*)(F.ws + WS_COSR); float* sinr = (float*)(F.ws + WS_SINR);
    for (int i = gt; i < SEQ * 32; i += NGT) { const int pos = i >> 5, d = i & 31; const double inv = exp2(-(double)(2 * d) / 64.0 * 13.287712379549449); double s, c; sincos((double)pos * inv, &s, &c); cosa[i] = (float)c; sina[i] = (float)s; }
    for (int i = gt; i < SEQ * 128; i += NGT) { const int pos = i >> 7, d = i & 127; const double inv = exp2(-((double)d / 127.0) * 13.287712379549449); double s, c; sincos((double)pos * inv, &s, &c); cosr[i] = (float)c; sinr[i] = (float)s; }
    float* ss = (float*)(F.ws + WS_SS);
    for (int i = gt; i < M * 4; i += NGT) ss[i] = 0.f;
}
using pg8::Unit;
typedef const pg8::f32x4 (&AccRef)[2][2][4][2];
typedef pg8::f32x4 (&AccMut)[2][2][4][2];

#ifndef WT_STORES
#define WT_STORES 0
#endif
__device__ __forceinline__ void st16(void* p, v4u v) {
#if WT_STORES
    asm volatile("global_store_dwordx4 %0, %1, off sc1\n\ts_nop 1" :: "v"(p), "v"(v) : "memory");
#else
    *(v4u*)p = v;
#endif
}
__device__ __forceinline__ float sigmoidf_(float v) { return __builtin_amdgcn_rcpf(1.f + __builtin_amdgcn_exp2f(v * -1.4426950408889634f)); }
__device__ __forceinline__ float lg2gamma(int h) { return log2f(1.f - exp2f(-5.f - (float)h)); }

struct SchedPlain {
    pg8::TileOrder T; const char* A; const char* B; int lda, ldb, nt, pn0;
    __device__ bool next(int i, Unit& u) const {
        int pm, pn; if (!T.tile(i, pm, pn)) return false;
        u.A = A + (size_t)pm * 256 * lda * 2; u.B = B + (size_t)(pn0 + pn) * 256 * ldb * 2; u.rows = nullptr; u.nt = nt; u.pm = pm; u.pn = pn0 + pn; u.part = 0; u.aux = 0; u.fin = true; return true;
    }
};

struct SchedConstAB {
    SchedPlain S;
    __device__ bool next(int i, Unit& u) const { if (!S.next(i, u)) return false; u.A = S.A; u.B = S.B; return true; }
};
struct EpiNull {
    static constexpr bool PERM = true; static constexpr bool SIGNAL = false;
    __device__ __forceinline__ void operator()(AccRef acc, const Unit& u, int, int, int, int) const {
#pragma unroll
        for (int a = 0; a < 2; ++a)
#pragma unroll
            for (int b = 0; b < 2; ++b)
#pragma unroll
                for (int m = 0; m < 4; ++m)
#pragma unroll
                    for (int n = 0; n < 2; ++n) asm volatile("" :: "v"(acc[a][b][m][n]));
    }
};
struct EpiStoreOnly {
    static constexpr bool PERM = true; static constexpr bool SIGNAL = false;
    bf16* O;
    __device__ __forceinline__ void operator()(AccRef acc, const Unit& u, int wr, int wc, int fr, int fq) const {
        const int row0 = u.pm * 256 + wr * 64 + fr, cl = 32 * wc + 8 * fq;
#pragma unroll
        for (int bj = 0; bj < 2; ++bj)
#pragma unroll
            for (int ai = 0; ai < 2; ++ai)
#pragma unroll
                for (int m = 0; m < 4; ++m) { v4u w;
#pragma unroll
                    for (int n = 0; n < 2; ++n) { const pg8::f32x4 v = acc[ai][bj][m][n]; w[2 * n] = pg8::cvt_pk_bf16(v[0], v[1]); w[2 * n + 1] = pg8::cvt_pk_bf16(v[2], v[3]); }
                    *(v4u*)(O + (size_t)(row0 + ai * 128 + m * 16) * 1024 + ((u.pn & 3) * 256) + 128 * bj + cl) = w; }
    }
};
struct EpiProj {
    static constexpr bool PERM = true; static constexpr bool SIGNAL = false;
    unsigned char* ws; bf16* outb; const float* const* in;
    __device__ __forceinline__ void operator()(AccRef acc, const Unit& u, int wr, int wc, int fr, int fq) const {
        const int T = u.pn;
        const int row0 = u.pm * 256 + wr * 64 + fr;
        if (T < 8) {
            bf16* QA = (bf16*)(ws + WS_QA); bf16* KA = (bf16*)(ws + WS_KA); const float* cosa = (const float*)(ws + WS_COSA); const float* sina = (const float*)(ws + WS_SINA); const float* gq = in[4]; const float* gk = in[5];
            const bool isq = T < 4; const float* g = isq ? gq : gk; bf16* O = isq ? QA : KA;
            const int head = 4 * (T & 3) + wc;
            f32x4 glo[2], ghi[2];
#pragma unroll
            for (int n = 0; n < 2; ++n) { glo[n] = *(const f32x4*)(g + 8 * fq + 4 * n); ghi[n] = *(const f32x4*)(g + 32 + 8 * fq + 4 * n); }
            f32x4 tb[3][4];
#define EP_LOADA(G) do { const int pos_ = (row0 + ((G) >> 2) * 128 + ((G) & 3) * 16) & (SEQ - 1); \
                _Pragma("unroll") for (int n = 0; n < 2; ++n) { tb[(G) % 3][2 * n] = *(const f32x4*)(cosa + pos_ * 32 + 8 * fq + 4 * n); tb[(G) % 3][2 * n + 1] = *(const f32x4*)(sina + pos_ * 32 + 8 * fq + 4 * n); } } while (0)
            EP_LOADA(0); EP_LOADA(1);
#pragma unroll
            for (int g8 = 0; g8 < 8; ++g8) { const int ai = g8 >> 2, m = g8 & 3; {
                    if (g8 + 2 < 8) EP_LOADA(g8 + 2);
                    const int row = row0 + ai * 128 + m * 16;
                    float ss = 0.f;
#pragma unroll
                    for (int bj = 0; bj < 2; ++bj)
#pragma unroll
                        for (int n = 0; n < 2; ++n) { const pg8::f32x4 v = acc[ai][bj][m][n]; ss += (v[0] * v[0] + v[1] * v[1]) + (v[2] * v[2] + v[3] * v[3]); }
                    { auto r16 = __builtin_amdgcn_permlane16_swap(__float_as_uint(ss), __float_as_uint(ss), false, false); ss = __uint_as_float(r16[0]) + __uint_as_float(r16[1]);
                      auto r32 = __builtin_amdgcn_permlane32_swap(__float_as_uint(ss), __float_as_uint(ss), false, false); ss = __uint_as_float(r32[0]) + __uint_as_float(r32[1]); }
                    const float rinv = __builtin_amdgcn_rsqf(ss * (1.f / 64.f) + EPS) * (isq ? C2 : 1.f);
                    v4u wlo, whi;
#pragma unroll
                    for (int n = 0; n < 2; ++n) {
                        const f32x4 c = tb[g8 % 3][2 * n], s = tb[g8 % 3][2 * n + 1];
                        const f32x4 lo = acc[ai][0][m][n] * rinv * glo[n], hi = acc[ai][1][m][n] * rinv * ghi[n];
                        const f32x4 olo = lo * c - hi * s, ohi = hi * c + lo * s;
                        wlo[2 * n] = pg8::cvt_pk_bf16(olo[0], olo[1]); wlo[2 * n + 1] = pg8::cvt_pk_bf16(olo[2], olo[3]);
                        whi[2 * n] = pg8::cvt_pk_bf16(ohi[0], ohi[1]); whi[2 * n + 1] = pg8::cvt_pk_bf16(ohi[2], ohi[3]);
                    }
                    bf16* p = O + (size_t)row * 1024 + head * 64 + 8 * fq;
                    st16(p, wlo); st16(p + 32, whi);
                } }
#undef EP_LOADA
        } else if (T >= 12 && T < 20) {
            bf16* QR = (bf16*)(ws + WS_QR); bf16* KR = (bf16*)(ws + WS_KR); const float* cosr = (const float*)(ws + WS_COSR); const float* sinr = (const float*)(ws + WS_SINR);
            const bool isq = T < 16; bf16* O = isq ? QR : KR; const int head = T & 3;
            const float lg = lg2gamma(head);
            f32x4 tb[3][4];
#define EP_LOADR(G) do { const int pos_ = (row0 + ((G) >> 2) * 128 + ((G) & 3) * 16) & (SEQ - 1); \
                _Pragma("unroll") for (int n = 0; n < 2; ++n) { tb[(G) % 3][2 * n] = *(const f32x4*)(cosr + pos_ * 128 + 32 * wc + 8 * fq + 4 * n); tb[(G) % 3][2 * n + 1] = *(const f32x4*)(sinr + pos_ * 128 + 32 * wc + 8 * fq + 4 * n); } } while (0)
            EP_LOADR(0); EP_LOADR(1);
#pragma unroll
            for (int g8 = 0; g8 < 8; ++g8) { const int ai = g8 >> 2, m = g8 & 3; {
                    if (g8 + 2 < 8) EP_LOADR(g8 + 2);
                    const int row = row0 + ai * 128 + m * 16, pos = row & (SEQ - 1), ic = pos & (RCH - 1);
                    const float fac = isq ? exp2f((float)ic * lg) : exp2f(-(float)ic * lg) * 0.0625f;
                    v4u wlo, whi;
#pragma unroll
                    for (int n = 0; n < 2; ++n) {
                        const f32x4 c = tb[g8 % 3][2 * n], s = tb[g8 % 3][2 * n + 1];
                        const f32x4 lo = acc[ai][0][m][n] * fac, hi = acc[ai][1][m][n] * fac;
                        const f32x4 olo = lo * c - hi * s, ohi = hi * c + lo * s;
                        wlo[2 * n] = pg8::cvt_pk_bf16(olo[0], olo[1]); wlo[2 * n + 1] = pg8::cvt_pk_bf16(olo[2], olo[3]);
                        whi[2 * n] = pg8::cvt_pk_bf16(ohi[0], ohi[1]); whi[2 * n + 1] = pg8::cvt_pk_bf16(ohi[2], ohi[3]);
                    }
                    bf16* p = isq ? O + ((size_t)((row >> 5) * 4 + head) * 16 + 2 * wc + (fq >> 1)) * 512 + ((fq & 1) * 32 + (row & 31)) * 8 : O + (size_t)row * 1024 + head * 256 + 32 * wc + 8 * fq;
                    st16(p, wlo); st16(p + (isq ? 8 * 512 : 128), whi);
                } }
#undef EP_LOADR
        } else {
            bf16* VA = (bf16*)(ws + WS_VA); bf16* V01 = (bf16*)(ws + WS_V01); bf16* V23 = (bf16*)(ws + WS_V23); bf16* GR = outb; bf16* GA = outb; bf16* GB = outb + (size_t)M * 1024; const float* bgate = in[3];
            bf16* O; int ldo, col0, act = 0; const float* bias = nullptr;
            if (T < 12) { O = VA; ldo = 1024; col0 = 256 * (T - 8); }
            else if (T < 28) { const int hh = (T - 20) >> 1, sh = (T - 20) & 1; O = hh < 2 ? V01 : V23; ldo = 1024; col0 = (hh & 1) * 512 + 256 * sh; }
            else if (T < 36) { O = GR; ldo = 2048; col0 = 256 * (T - 28); act = 1; }
            else if (T < 40) { O = GA; ldo = 1024; col0 = 256 * (T - 36); act = 2; bias = bgate + col0; }
            else { O = GB; ldo = 1024; col0 = 256 * (T - 40); act = 2; bias = bgate + 1024 + col0; }
            const int cl = 32 * wc + 8 * fq;
#pragma unroll
            for (int bj = 0; bj < 2; ++bj) {
                f32x4 bv[2] = {(f32x4){0.f, 0.f, 0.f, 0.f}, (f32x4){0.f, 0.f, 0.f, 0.f}};
                if (bias) { bv[0] = *(const f32x4*)(bias + 128 * bj + cl); bv[1] = *(const f32x4*)(bias + 128 * bj + cl + 4); }
#pragma unroll
                for (int ai = 0; ai < 2; ++ai)
#pragma unroll
                    for (int m = 0; m < 4; ++m) {
                        const int row = row0 + ai * 128 + m * 16;
                        v4u w;
#pragma unroll
                        for (int n = 0; n < 2; ++n) {
                            f32x4 v = acc[ai][bj][m][n] + bv[n];
                            if (act == 1) { v[0] = v[0] * sigmoidf_(v[0]); v[1] = v[1] * sigmoidf_(v[1]); v[2] = v[2] * sigmoidf_(v[2]); v[3] = v[3] * sigmoidf_(v[3]); }
                            else if (act == 2) { v[0] = sigmoidf_(v[0]); v[1] = sigmoidf_(v[1]); v[2] = sigmoidf_(v[2]); v[3] = sigmoidf_(v[3]); }
                            w[2 * n] = pg8::cvt_pk_bf16(v[0], v[1]); w[2 * n + 1] = pg8::cvt_pk_bf16(v[2], v[3]);
                        }
                        st16(O + (size_t)row * ldo + col0 + 128 * bj + cl, w);
                    }
            }
        }
    }
};

struct SchedMix {
    pg8::TileOrder T; const char* ATT; const char* W;
    __device__ bool next(int i, Unit& u) const {
        const int ti = i / 3, part = i - ti * 3; int pm, pn; if (!T.tile(ti, pm, pn)) return false;
        const size_t rowoff = (size_t)pm * 256 * 1024 * 2;
        u.A = ATT + (part == 0 ? (size_t)0 : (part == 1 ? (size_t)(WS_V01 - WS_QA) : (size_t)(WS_V23 - WS_QA))) + rowoff; u.B = W + (size_t)pn * 256 * 3072 * 2 + (size_t)part * 1024 * 2; u.nt = 16;
        u.rows = nullptr; u.pm = pm; u.pn = pn; u.part = part; u.aux = 0; u.fin = (part != 1); return true;
    }
};
struct EpiMix {
    static constexpr bool PERM = true; static constexpr bool SIGNAL = false;
    const bf16 *GA, *GB; bf16* M1; bf16* MRG;
    __device__ __forceinline__ void operator()(AccRef acc, const Unit& u, int wr, int wc, int fr, int fq) const {
        const int row0 = u.pm * 256 + wr * 64 + fr, colb = u.pn * 256 + 32 * wc + 8 * fq;
        const bool p0 = (u.part == 0); const bf16* G = p0 ? GA : GB;
#pragma unroll
        for (int ai = 0; ai < 2; ++ai)
#pragma unroll
            for (int m = 0; m < 4; ++m) {
                const size_t ro = (size_t)(row0 + ai * 128 + m * 16) * 1024 + colb;
#pragma unroll
                for (int bj = 0; bj < 2; ++bj) {
                    const v4u g = *(const v4u*)(G + ro + 128 * bj);
                    f32x4 v0 = acc[ai][bj][m][0], v1 = acc[ai][bj][m][1];
                    v0[0] *= bflo(g[0]); v0[1] *= bfhi(g[0]); v0[2] *= bflo(g[1]); v0[3] *= bfhi(g[1]);
                    v1[0] *= bflo(g[2]); v1[1] *= bfhi(g[2]); v1[2] *= bflo(g[3]); v1[3] *= bfhi(g[3]);
                    bf16* mp = M1 + ro + 128 * bj;
                    if (p0) { v4u w; w[0] = pg8::cvt_pk_bf16(v0[0], v0[1]); w[1] = pg8::cvt_pk_bf16(v0[2], v0[3]); w[2] = pg8::cvt_pk_bf16(v1[0], v1[1]); w[3] = pg8::cvt_pk_bf16(v1[2], v1[3]); *(v4u*)mp = w; }
                    else { const v4u pm = *(const v4u*)mp;
                        v0[0] += bflo(pm[0]); v0[1] += bfhi(pm[0]); v0[2] += bflo(pm[1]); v0[3] += bfhi(pm[1]); v1[0] += bflo(pm[2]); v1[1] += bfhi(pm[2]); v1[2] += bflo(pm[3]); v1[3] += bfhi(pm[3]);
                        v4u w; w[0] = pg8::cvt_pk_bf16(v0[0], v0[1]); w[1] = pg8::cvt_pk_bf16(v0[2], v0[3]); w[2] = pg8::cvt_pk_bf16(v1[0], v1[1]); w[3] = pg8::cvt_pk_bf16(v1[2], v1[3]);
                        *(v4u*)(MRG + ro + 128 * bj) = w; }
                }
                asm volatile("" ::: "memory");
            }
    }
};

struct EpiOut {
    static constexpr bool PERM = false; static constexpr bool SIGNAL = false;
    const float* X; float* O;
    __device__ __forceinline__ void operator()(AccRef acc, const Unit& u, int wr, int wc, int fr, int fq) const {
        const int row0 = u.pm * 256 + wr * 64 + fr, col0 = u.pn * 256 + wc * 32 + 4 * fq;
        const size_t off0 = (size_t)row0 * D + col0;
        f32x4 xb[3][4];
#define EO_LOAD(G) do { const size_t off_ = off0 + (size_t)(((G) >> 2) * 128 + ((G) & 3) * 16) * D; \
            _Pragma("unroll") for (int bj = 0; bj < 2; ++bj) _Pragma("unroll") for (int n = 0; n < 2; ++n) xb[(G) % 3][2 * bj + n] = *(const f32x4*)(X + off_ + bj * 128 + n * 16); } while (0)
        EO_LOAD(0); EO_LOAD(1);
#pragma unroll
        for (int g = 0; g < 8; ++g) { const int ai = g >> 2, m = g & 3; const size_t off = off0 + (size_t)(ai * 128 + m * 16) * D;
            if (g + 2 < 8) EO_LOAD(g + 2);
#pragma unroll
            for (int bj = 0; bj < 2; ++bj)
#pragma unroll
                for (int n = 0; n < 2; ++n) *(f32x4*)(O + off + bj * 128 + n * 16) = xb[g % 3][2 * bj + n] + acc[ai][bj][m][n]; }
#undef EO_LOAD
    }
};


__device__ __forceinline__ void attn_simple(Frame& F) {
    const bf16* QA = (const bf16*)(F.ws + WS_QA); const bf16* KA = (const bf16*)(F.ws + WS_KA); const bf16* VA = (const bf16*)(F.ws + WS_VA); bf16* O = (bf16*)(F.ws + WS_QA);
    const int gw = F.vcu * NWAVES + F.wave, NGW = F.G * NWAVES, d = F.lane;
    for (int task = gw; task < M * AH; task += NGW) {
        const int h = task & 15, tok = task >> 4, b = tok >> 11, t = tok & (SEQ - 1);
        const float q = bf2f(QA[(size_t)tok * 1024 + h * 64 + d]);
        float mx = -INFINITY, l = 0.f, o = 0.f;
#pragma unroll 1
        for (int p = 0; p < 3; ++p) {
            const int r = p == 0 ? 1 : (p == 1 ? 4 : 16);
#pragma unroll 2
            for (int j = 0; j <= 128; ++j) {
                const int s = t - r * j; if (s < 0) break;
                const size_t ko = (size_t)(b * SEQ + s) * 1024 + h * 64 + d;
                const float sc = wave_sum(q * bf2f(KA[ko]));
                const float mn = fmaxf(mx, sc), corr = exp2f(mx - mn), pj = exp2f(sc - mn);
                l = l * corr + pj; o = o * corr + pj * bf2f(VA[ko]); mx = mn;
            }
        }
        O[(size_t)tok * 1024 + h * 64 + d] = (bf16)f2bf(o / l);
    }
}

__device__ __forceinline__ void ret_simple_chunk(Frame& F, int n) {
    const bf16* QR = (const bf16*)(F.ws + WS_QR); const bf16* KR = (const bf16*)(F.ws + WS_KR);
    const bf16* GR = (const bf16*)F.out; bf16* TMP = (bf16*)(F.ws + WS_TMP); float* SS = (float*)(F.ws + WS_SS);
    const int gw = F.vcu * NWAVES + F.wave, NGW = F.G * NWAVES, lane = F.lane;
    for (int task = gw; task < NB * RH * RCH; task += NGW) {
        const int i = task & 127, h = (task >> 7) & 3, b = task >> 9, t = n * RCH + i, tok = b * SEQ + t;
        const bf16* V = (const bf16*)(F.ws + (h < 2 ? WS_V01 : WS_V23));
        const float lg = lg2gamma(h);
        const v2u qw = *(const v2u*)(QR + (size_t)tok * 1024 + h * 256 + 4 * lane);
        const float q0 = bflo(qw[0]), q1 = bfhi(qw[0]), q2 = bflo(qw[1]), q3 = bfhi(qw[1]);
        float y[8];
#pragma unroll
        for (int e = 0; e < 8; ++e) y[e] = 0.f;
        for (int s = 0; s <= t; ++s) {
            const size_t srow = (size_t)(b * SEQ + s);
            const v2u kw = *(const v2u*)(KR + srow * 1024 + h * 256 + 4 * lane);
            float dot = q0 * bflo(kw[0]) + q1 * bfhi(kw[0]) + q2 * bflo(kw[1]) + q3 * bfhi(kw[1]);
            dot = wave_sum(dot) * exp2f((float)(RCH * (n - (s >> 7))) * lg);
            const v4u vw = *(const v4u*)(V + srow * 1024 + (h & 1) * 512 + 8 * lane);
#pragma unroll
            for (int e = 0; e < 4; ++e) { y[2 * e] += dot * bflo(vw[e]); y[2 * e + 1] += dot * bfhi(vw[e]); }
        }
        float ss = 0.f;
#pragma unroll
        for (int e = 0; e < 8; ++e) ss += y[e] * y[e];
        ss = wave_sum(ss);
        if (lane == 0) SS[tok * 4 + h] = ss;
        const float rinv = 1.f / sqrtf(ss * (1.f / 512.f) + EPS);
        const float* g = F.in[7] + h * 512 + 8 * lane;
        const v4u gw4 = *(const v4u*)(GR + (size_t)tok * 2048 + h * 512 + 8 * lane);
        v4u w;
#pragma unroll
        for (int e = 0; e < 4; ++e) w[e] = pk2(y[2 * e] * rinv * g[2 * e] * bflo(gw4[e]), y[2 * e + 1] * rinv * g[2 * e + 1] * bfhi(gw4[e]));
        *(v4u*)(TMP + ((size_t)(b * RCH + i) * 2048 + h * 512 + 8 * lane)) = w;
    }
}
__device__ __forceinline__ void ret_simple_copy(Frame& F, int n) {
    const bf16* TMP = (const bf16*)(F.ws + WS_TMP);
    const int gt = (F.vcu * NWAVES + F.wave) * 64 + F.lane, NGT = F.G * NWAVES * 64;
    for (int idx = gt; idx < NB * RCH * 256; idx += NGT) {
        const int c8 = idx & 255, i = (idx >> 8) & 127, b = idx >> 15, col = c8 * 8, h = col >> 9;
        bf16* V = (bf16*)(F.ws + (h < 2 ? WS_V01 : WS_V23));
        *(v4u*)(V + (size_t)(b * SEQ + n * RCH + i) * 1024 + (h & 1) * 512 + (col & 511)) = *(const v4u*)(TMP + (size_t)(b * RCH + i) * 2048 + col);
    }
}
typedef float f32x16 __attribute__((ext_vector_type(16)));
typedef short s16x4 __attribute__((ext_vector_type(4)));
typedef short v4i16_t __attribute__((ext_vector_type(4)));
#define MFMA32(a, b, c) __builtin_amdgcn_mfma_f32_32x32x16_bf16((a), (b), (c), 0, 0, 0)
__device__ __forceinline__ int crow(int r, int hi) { return (r & 3) + 8 * (r >> 2) + 4 * hi; }
__device__ __forceinline__ s16x4 vtr(const LAS unsigned char* p) { return __builtin_bit_cast(s16x4, __builtin_amdgcn_ds_read_tr16_b64_v4i16((LAS v4i16_t*)p)); }
__device__ __forceinline__ float half_max(float m) { auto rr = __builtin_amdgcn_permlane32_swap(__float_as_uint(m), __float_as_uint(m), false, false); return fmaxf(__uint_as_float(rr[0]), __uint_as_float(rr[1])); }
__device__ __forceinline__ float half_sum(float m) { auto rr = __builtin_amdgcn_permlane32_swap(__float_as_uint(m), __float_as_uint(m), false, false); return __uint_as_float(rr[0]) + __uint_as_float(rr[1]); }
__device__ __forceinline__ bf16x8 pack8(const f32x16& p, int s) {
    v4u w; w[0] = pg8::cvt_pk_bf16(p[8 * s], p[8 * s + 1]); w[1] = pg8::cvt_pk_bf16(p[8 * s + 2], p[8 * s + 3]); w[2] = pg8::cvt_pk_bf16(p[8 * s + 4], p[8 * s + 5]); w[3] = pg8::cvt_pk_bf16(p[8 * s + 6], p[8 * s + 7]);
    return __builtin_bit_cast(bf16x8, w);
}
constexpr int AT_OACC = 0;
constexpr int AT_MS = 65536, AT_LS = 67584;
constexpr int AT_WSF = 69632;
constexpr int AT_VB = 73728;
constexpr int AT_KB = AT_VB + 8 * 4096;
static_assert(AT_KB + 8 * 4096 <= LDSCTL_OFF, "attention LDS map");

#ifndef AABL
#define AABL 0
#endif
struct AttnTask { int b, h, U0, r, c, g, st, kt0; bool valid; };
__device__ __forceinline__ AttnTask attn_desc(const Frame& F, int i) {
    AttnTask T; const int ui = i / 6, rem = i - ui * 6; T.st = rem >> 1; const int tt = rem & 1;
    const int idx = F.vcu + ui * F.G; T.valid = idx < 512;
    const int rnd = idx >> 8, v8 = idx & 255, bh = 64 * rnd + (v8 >> 2), G = rnd == 0 ? (v8 & 3) : 3 - (v8 & 3);
    T.b = bh >> 4; T.h = bh & 15; T.U0 = 512 * G;
    T.r = T.st == 0 ? 1 : (T.st == 1 ? 4 : 16); const int npc = 16 / T.r, tau = F.wave * 2 + tt;
    T.c = tau / npc; T.g = tau % npc;
    const int iq0 = T.U0 / T.r + 32 * T.g; const int kt = 4 - (iq0 >> 5); T.kt0 = kt < 0 ? 0 : kt;
    return T;
}
__device__ __forceinline__ void attention_phase(Frame& F, bf16* O, const int abl) {
    const bf16* QA = (const bf16*)(F.ws + WS_QA); const bf16* KA = (const bf16*)(F.ws + WS_KA); const bf16* VA = (const bf16*)(F.ws + WS_VA);
    const int lane = F.lane, r32 = lane & 31, hi = lane >> 5, wave = F.wave;
    LAS unsigned char* lds = F.lds + RING_OFF;
    LAS float* wsf = (LAS float*)(lds + AT_WSF) + wave * 128;
    LAS unsigned char* vb = lds + AT_VB + wave * 4096;
    LAS unsigned char* kb = lds + AT_KB + wave * 4096;
    const LAS unsigned char* krd = kb + r32 * 128;
    const int kxr = 16 * (hi ^ ((r32 >> 1) & 7));
    const LAS unsigned char* vrd = vb + ((lane >> 4) & 1) * 32 + (lane & 3) * 8 + (4 * hi + ((lane & 15) >> 2)) * 64;
    const int vkk = lane >> 3, vch = lane & 7;
    bf16x8 qn[4]; v4u kn[4], vn[4];
#define AT_PREFETCH(TT, KT) do { const size_t rowb_ = (size_t)(TT).b * SEQ; const int ik0_ = (TT).U0 / (TT).r + 32 * (TT).g - 128 + 32 * (KT); \
        _Pragma("unroll") for (int i_ = 0; i_ < 4; ++i_) kn[i_] = *(const v4u*)(KA + (rowb_ + (TT).c + (TT).r * (ik0_ + vkk + 8 * i_)) * 1024 + (TT).h * 64 + 8 * vch); \
        _Pragma("unroll") for (int i_ = 0; i_ < 4; ++i_) vn[i_] = *(const v4u*)(VA + (rowb_ + (TT).c + (TT).r * (ik0_ + vkk + 8 * i_)) * 1024 + (TT).h * 64 + 8 * vch); } while (0)
#define AT_FIRST(TT) do { const bf16* qp_ = QA + ((size_t)(TT).b * SEQ + (TT).c + (TT).r * ((TT).U0 / (TT).r + 32 * (TT).g + r32)) * 1024 + (TT).h * 64 + 8 * hi; \
        _Pragma("unroll") for (int s = 0; s < 4; ++s) qn[s] = *(const bf16x8*)(qp_ + 16 * s); \
        AT_PREFETCH(TT, (TT).kt0); } while (0)
    AttnTask T = attn_desc(F, 0);
    if (T.valid) AT_FIRST(T);
#pragma unroll 1
    for (int ti = 0; T.valid; ++ti) {
        const AttnTask N = attn_desc(F, ti + 1);
        bf16x8 qf[4];
#pragma unroll
        for (int s = 0; s < 4; ++s) qf[s] = qn[s];
        float m = -1e30f, l = 0.f;
        f32x16 o0, o1;
#pragma unroll
        for (int i = 0; i < 16; ++i) { o0[i] = 0.f; o1[i] = 0.f; }
#pragma unroll 1
        for (int kt = T.kt0; kt <= 4; ++kt) {
#pragma unroll
            for (int i = 0; i < 4; ++i) *(LAS v4u*)(kb + (vkk + 8 * i) * 128 + 16 * (vch ^ (((vkk >> 1) + 4 * i) & 7))) = kn[i];
#pragma unroll
            for (int i = 0; i < 4; ++i) *(LAS v4u*)(vb + (vch >> 2) * 2048 + (vkk + 8 * i) * 64 + (vch & 3) * 16) = vn[i];
            bf16x8 kf[4];
#pragma unroll
            for (int s = 0; s < 4; ++s) kf[s] = *(const LAS bf16x8*)(krd + ((32 * s) ^ kxr));
            if (kt < 4) { if (!(abl & 1)) AT_PREFETCH(T, kt + 1); } else if (N.valid) AT_FIRST(N);
            if (abl & 8) { asm volatile("" :: "v"(kf[0]), "v"(kf[1]), "v"(kf[2]), "v"(kf[3])); continue; }
            f32x16 p;
#pragma unroll
            for (int i = 0; i < 16; ++i) p[i] = 0.f;
#pragma unroll
            for (int s = 0; s < 4; ++s) p = MFMA32(kf[s], qf[s], p);
            if (kt == 0) {
#pragma unroll
                for (int i = 0; i < 16; ++i) if (crow(i, hi) < r32) p[i] = -INFINITY;
            }
            if (kt == 4) {
#pragma unroll
                for (int i = 0; i < 16; ++i) if (crow(i, hi) > r32) p[i] = -INFINITY;
            }
            float tm = p[0];
#pragma unroll
            for (int i = 1; i < 16; ++i) tm = fmaxf(tm, p[i]);
            tm = half_max(tm);
            const float mn = fmaxf(m, tm), corr = __builtin_amdgcn_exp2f(m - mn);
            m = mn;
            float ps = 0.f;
#pragma unroll
            for (int i = 0; i < 16; ++i) { p[i] = __builtin_amdgcn_exp2f(p[i] - mn); ps += p[i]; }
            l = l * corr + ps;
            if (hi == 0) wsf[r32] = corr;
            const bf16x8 pa0 = pack8(p, 0), pa1 = pack8(p, 1);
#pragma unroll
            for (int i = 0; i < 16; ++i) { const float f = wsf[crow(i, hi)]; o0[i] *= f; o1[i] *= f; }
#pragma unroll
            for (int s = 0; s < 2; ++s) {
                const s16x4 a0 = vtr(vrd + s * 1024), a1 = vtr(vrd + s * 1024 + 512), b0 = vtr(vrd + 2048 + s * 1024), b1 = vtr(vrd + 2048 + s * 1024 + 512);
                const bf16x8 v0 = (bf16x8){a0[0], a0[1], a0[2], a0[3], a1[0], a1[1], a1[2], a1[3]}, v1 = (bf16x8){b0[0], b0[1], b0[2], b0[3], b1[0], b1[1], b1[2], b1[3]};
                o0 = MFMA32(s == 0 ? pa0 : pa1, v0, o0); o1 = MFMA32(s == 0 ? pa0 : pa1, v1, o1);
            }
        }
        if (!(abl & 4)) {
            l = half_sum(l);
            LAS float* MS = (LAS float*)(lds + AT_MS); LAS float* LS = (LAS float*)(lds + AT_LS);
            const int offq = T.c + T.r * (32 * T.g + r32);
            float fa = 0.f, fb = 1.f / l;
            if (T.st != 0) {
                const float mo = MS[offq], lo = LS[offq];
                const float mm = fmaxf(mo, m), wa = lo * __builtin_amdgcn_exp2f(mo - mm), wb = l * __builtin_amdgcn_exp2f(m - mm), ln = wa + wb;
                fa = wa / ln; fb = (wb / ln) / l; m = mm; l = ln;
            }
            if (hi == 0) { MS[offq] = m; LS[offq] = l; wsf[r32] = fa; wsf[32 + r32] = fb; }
            LAS unsigned short* OA = (LAS unsigned short*)(lds + AT_OACC);
            if (T.st == 0) {
#pragma unroll
                for (int i = 0; i < 16; ++i) { const int qq = crow(i, hi), off = T.c + T.r * (32 * T.g + qq); const float gb = wsf[32 + qq];
                    OA[off * 64 + r32] = (unsigned short)f2bf(gb * o0[i]); OA[off * 64 + 32 + r32] = (unsigned short)f2bf(gb * o1[i]); }
            } else {
#pragma unroll
                for (int i = 0; i < 16; ++i) { const int qq = crow(i, hi), off = T.c + T.r * (32 * T.g + qq); const float ga = wsf[qq], gb = wsf[32 + qq];
                    OA[off * 64 + r32] = (unsigned short)f2bf(gb * o0[i] + ga * bf2f(OA[off * 64 + r32])); OA[off * 64 + 32 + r32] = (unsigned short)f2bf(gb * o1[i] + ga * bf2f(OA[off * 64 + 32 + r32])); }
            }
        }
        if (ti & 1) {
            __syncthreads();
            if (T.st == 2) {
#pragma unroll
                for (int it = 0; it < 8; ++it) { const int pi = it * 512 + F.tid, row = pi >> 3, ch = pi & 7;
                    *(v4u*)(O + ((size_t)T.b * SEQ + T.U0 + row) * 1024 + T.h * 64 + ch * 8) = *(const LAS v4u*)(lds + AT_OACC + row * 128 + ch * 16); }
                __syncthreads();
            }
        }
        T = N;
    }
#undef AT_PREFETCH
#undef AT_FIRST
}

constexpr int RT_KI = 0;
constexpr int RT_VI = 65536;
constexpr int RT_PI = 81920;
constexpr int RT_PFJ = 150016;
constexpr int RT_ST = 114688;
constexpr int RT_RS = 147456;
static_assert(RT_RS + 512 <= LDSCTL_OFF, "retention LDS map");
__device__ __forceinline__ int swz16(int row) { return ((row & 3) << 2) | ((row >> 2) & 3); }
__device__ __forceinline__ int koff(int j, int ch) { return 512 * j + 16 * (ch ^ swz16(j)); }
__device__ __forceinline__ int pioff(int i, int ch) { return 256 * i + 16 * (ch ^ swz16(i)); }
__device__ __forceinline__ int voff(int j, int ch) { return 128 * j + 16 * (ch ^ (((j >> 1) & 1) << 2)); }

#define LAUNDER(x) asm volatile("" : "+v"(x))
#define LAUNDER(x) asm volatile("" : "+v"(x))
#ifndef RABL
#define RABL 0
#endif
#ifndef RPF
#define RPF 0
#endif
#ifndef RPF_DIST
#define RPF_DIST 3
#endif
__device__ __forceinline__ void retention_phase(Frame& F, const bool dummy) {
    const int abl = dummy ? RABL : 0;
    const int tid = F.tid, lane = F.lane, r32 = lane & 31, hi = lane >> 5, w = F.wave;
    const int tq = (lane & 15) >> 2, tp = lane & 3, tblk = (lane >> 4) & 1;
    LAS unsigned char* lds = F.lds + RING_OFF;
    const bf16* QR = (const bf16*)(F.ws + WS_QR); const bf16* KR = (const bf16*)(F.ws + WS_KR);
    const int ib = w >> 1, cb = w & 1;
    const int sw = swz16(r32);
    for (int idx = F.vcu; idx < 256; idx += F.G) {
        const int bh = idx >> 3, dvs = idx & 7, b = bh >> 2, h = bh & 3;
        bf16* Vb = (bf16*)(F.ws + (h < 2 ? WS_V01 : WS_V23)) + (h & 1) * 512 + 64 * dvs;
        const float lg = lg2gamma(h), gam = exp2f(lg), gC = exp2f(128.f * lg), gC1 = exp2f(127.f * lg);
        f32x16 st0, st1;
#pragma unroll
        for (int i = 0; i < 16; ++i) { st0[i] = 0.f; st1[i] = 0.f; }
        v4u kx[8], vx[2]; bf16x8 qf[16];
#define RT_LOAD_KV(N) do { const size_t r0_ = (size_t)b * SEQ + 128 * (N); int tidl_ = tid; LAUNDER(tidl_); \
            _Pragma("unroll") for (int it = 0; it < 8; ++it) { const int q = it * 512 + tidl_, j = q >> 5, ch = q & 31; kx[it] = *(const v4u*)(KR + (r0_ + j) * 1024 + h * 256 + 8 * ch); } \
            _Pragma("unroll") for (int it = 0; it < 2; ++it) { const int q = it * 512 + tidl_, j = q >> 3, ch = q & 7; vx[it] = *(const v4u*)(Vb + (r0_ + j) * 1024 + 8 * ch); } } while (0)
#define RT_STORE_KV() do { \
            _Pragma("unroll") for (int it = 0; it < 8; ++it) { const int q = it * 512 + tid, j = q >> 5, ch = q & 31; *(LAS v4u*)(lds + RT_KI + koff(j, ch)) = kx[it]; } \
            _Pragma("unroll") for (int it = 0; it < 2; ++it) { const int q = it * 512 + tid, j = q >> 3, ch = q & 7; *(LAS v4u*)(lds + RT_VI + voff(j, ch)) = vx[it]; } } while (0)
#define RT_BAR() asm volatile("s_waitcnt lgkmcnt(0)\n\ts_barrier" ::: "memory")
#define RT_LOAD_Q(N) do { int lnl_ = lane; LAUNDER(lnl_); const bf16* qp_ = QR + ((size_t)((b * SEQ + 128 * (N)) / 32 + ib) * 4 + h) * 8192 + 8 * lnl_;     \
            _Pragma("unroll") for (int s = 0; s < 16; ++s) qf[s] = *(const bf16x8*)(qp_ + 512 * s); } while (0)
#define RT_PREFETCH(N) do { if (RPF && (N) < 16 && tid < 256) { const size_t r0_ = (size_t)b * SEQ + 128 * (N); const bf16* p_; const int l_ = dvs * 64 + (tid & 63); \
            if (tid < 64) p_ = KR + (r0_ + (l_ >> 2)) * 1024 + h * 256 + 64 * (l_ & 3); else if (tid < 128) p_ = QR + ((size_t)(r0_ / 32 + (l_ >> 7)) * 4 + h) * 8192 + 64 * (l_ & 127); else p_ = Vb + (r0_ + (tid - 128)) * 1024; \
            unsigned sv_; asm volatile("s_mov_b32 %0, m0\n\ts_mov_b32 m0, %2\n\ts_nop 0\n\tglobal_load_lds_dword %1, off\n\ts_mov_b32 m0, %0" : "=&s"(sv_) : "v"(p_), "s"(pfbase)); } } while (0)
        const unsigned pfbase = __builtin_amdgcn_readfirstlane((unsigned)(size_t)F.lds + RT_PFJ + 256 * (w & 3));
        __syncthreads();
        RT_LOAD_KV(0); RT_LOAD_Q(0);
        RT_PREFETCH(1); RT_PREFETCH(2);
        for (int q = tid; q < 32768 / 16; q += 512) *(LAS v4u*)(lds + RT_ST + q * 16) = (v4u){0u, 0u, 0u, 0u};
        RT_STORE_KV();
        __syncthreads();
#pragma unroll 1
        for (int n = 0; n < 16; ++n) {
            const size_t row0 = (size_t)b * SEQ + 128 * n;
            int LX = 16 * (hi ^ sw), SWB = 16 * sw;
            LAUNDER(LX); LAUNDER(SWB);
            int r32l = r32, hil = hi; LAUNDER(r32l); LAUNDER(hil);
#pragma unroll 1
            for (int jj = 0; jj < 2; ++jj) {
                const int jb = 2 * jj + cb;
                if (jb <= ib && !(abl & 2)) {
                    f32x16 p;
#pragma unroll
                    for (int i = 0; i < 16; ++i) p[i] = 0.f;
                    const LAS unsigned char* kr = lds + RT_KI + 512 * (32 * jb + r32);
#pragma unroll
                    for (int s = 0; s < 16; ++s) { const bf16x8 kf = *(const LAS bf16x8*)(kr + ((32 * s) ^ LX)); p = MFMA32(kf, qf[s], p); }
                    if (jb == ib) {
#pragma unroll
                        for (int i = 0; i < 16; ++i) if (crow(i, hi) > r32) p[i] = 0.f;
                    }
                    LAS unsigned char* pw = lds + RT_PI + 256 * (32 * ib + r32) + 8 * hi;
#pragma unroll
                    for (int g = 0; g < 4; ++g) { v2u wv; wv[0] = pg8::cvt_pk_bf16(p[4 * g], p[4 * g + 1]); wv[1] = pg8::cvt_pk_bf16(p[4 * g + 2], p[4 * g + 3]);
                        *(LAS v2u*)(pw + ((64 * jb + 16 * g) ^ SWB)) = wv; }
                }
            }
            if (n < 15 && !(abl & 16)) RT_LOAD_KV(n + 1);
            RT_BAR();
            f32x16 ya, yc;
#pragma unroll
            for (int i = 0; i < 16; ++i) { ya[i] = 0.f; yc[i] = 0.f; }
            {
                const LAS unsigned char* pr = lds + RT_PI + 256 * (32 * ib + r32);
                const LAS unsigned char* vr = lds + RT_VI + voff(8 * hi + tq, 4 * cb + 2 * tblk + (tp >> 1)) + 8 * (tp & 1);
#pragma unroll
                for (int s = 0; s < 8; ++s) {
                    if (s < 2 * (ib + 1) && !(abl & 4)) {
                        const bf16x8 pa = *(const LAS bf16x8*)(pr + ((32 * s) ^ LX));
                        const s16x4 v0 = vtr(vr + 2048 * s), v1 = vtr(vr + 2048 * s + 512);
                        ya = MFMA32(((bf16x8){v0[0], v0[1], v0[2], v0[3], v1[0], v1[1], v1[2], v1[3]}), pa, ya);
                    }
                }
            }
            if (!(abl & 4)) { const LAS unsigned char* sr = lds + RT_ST + 512 * (32 * cb + r32);
#pragma unroll
              for (int s = 0; s < 16; ++s) { const bf16x8 sf = *(const LAS bf16x8*)(sr + ((32 * s) ^ LX)); yc = MFMA32(sf, qf[s], yc); } }
            if (n < 15 && !(abl & 16)) RT_LOAD_Q(n + 1);
            unsigned ypk[8];
#pragma unroll
            for (int i = 0; i < 8; ++i) ypk[i] = pk2(ya[2 * i] + gam * yc[2 * i], ya[2 * i + 1] + gam * yc[2 * i + 1]);
            if (!(abl & 8)) { f32x16 u0, u1;
#pragma unroll
              for (int i = 0; i < 16; ++i) { u0[i] = 0.f; u1[i] = 0.f; }
              const int kch = 4 * w + 2 * tblk + (tp >> 1);
              const LAS unsigned char* ka0 = lds + RT_KI + koff(8 * hi + tq, kch) + 8 * (tp & 1);
              const LAS unsigned char* ka1 = lds + RT_KI + koff(8 * hi + tq + 4, kch) + 8 * (tp & 1);
              const LAS unsigned char* va = lds + RT_VI + voff(8 * hi + tq, 2 * tblk + (tp >> 1)) + 8 * (tp & 1);
              const LAS unsigned char* vb2 = lds + RT_VI + voff(8 * hi + tq, 4 + 2 * tblk + (tp >> 1)) + 8 * (tp & 1);
#pragma unroll
              for (int s = 0; s < 8; ++s) {
                  const s16x4 k0 = vtr(ka0 + 8192 * s), k1 = vtr(ka1 + 8192 * s);
                  const bf16x8 ka = (bf16x8){k0[0], k0[1], k0[2], k0[3], k1[0], k1[1], k1[2], k1[3]};
                  const s16x4 a0 = vtr(va + 2048 * s), a1 = vtr(va + 2048 * s + 512), b0 = vtr(vb2 + 2048 * s), b1 = vtr(vb2 + 2048 * s + 512);
                  u0 = MFMA32(ka, ((bf16x8){a0[0], a0[1], a0[2], a0[3], a1[0], a1[1], a1[2], a1[3]}), u0);
                  u1 = MFMA32(ka, ((bf16x8){b0[0], b0[1], b0[2], b0[3], b1[0], b1[1], b1[2], b1[3]}), u1);
              }
#pragma unroll
              for (int i = 0; i < 16; ++i) { st0[i] = gC * st0[i] + gC1 * u0[i]; st1[i] = gC * st1[i] + gC1 * u1[i]; } }
            {
              const size_t tok = row0 + 32 * ib + r32l;
              bf16* yp = dummy ? (bf16*)(F.ws + WS_TMP) + (tok & 1023) * 1024 + 64 * dvs + 32 * cb + 4 * hil : Vb + tok * 1024 + 32 * cb + 4 * hil;
#pragma unroll
              for (int g = 0; g < 4; ++g) { v2u wv; wv[0] = ypk[2 * g]; wv[1] = ypk[2 * g + 1]; *(v2u*)(yp + 8 * g) = wv; } }
            RT_BAR();
            if (!(abl & 32)) { LAS unsigned char* sw0 = lds + RT_ST + 512 * r32 + 8 * hi; LAS unsigned char* sw1 = sw0 + 512 * 32;
#pragma unroll
              for (int g = 0; g < 4; ++g) {
                v2u w0, w1; w0[0] = pg8::cvt_pk_bf16(st0[4 * g], st0[4 * g + 1]); w0[1] = pg8::cvt_pk_bf16(st0[4 * g + 2], st0[4 * g + 3]);
                w1[0] = pg8::cvt_pk_bf16(st1[4 * g], st1[4 * g + 1]); w1[1] = pg8::cvt_pk_bf16(st1[4 * g + 2], st1[4 * g + 3]);
                const int o = (64 * w + 16 * g) ^ SWB;
                *(LAS v2u*)(sw0 + o) = w0; *(LAS v2u*)(sw1 + o) = w1;
              } }
            if (n < 15 && !(abl & 32)) RT_STORE_KV();
            RT_PREFETCH(n + RPF_DIST);
            RT_BAR();
        }
#undef RT_LOAD_KV
#undef RT_PREFETCH
#undef RT_STORE_KV
#undef RT_LOAD_Q
#undef RT_BAR
    }
}
__device__ __forceinline__ void retnorm_pass(Frame& F, const bool dummy = false) {
    const bf16* GR = (const bf16*)F.out;
    const int gw = F.vcu * NWAVES + F.wave, NGW = F.G * NWAVES, lane = F.lane;
    for (int m0 = gw; m0 < 4 * M; m0 += 2 * NGW) {
        bf16* Yp[2]; v4u yv[2], gv[2]; f32x4 g0[2], g1[2]; bool ok[2];
#pragma unroll
        for (int u = 0; u < 2; ++u) { int m = m0 + u * NGW; ok[u] = m < 4 * M; if (!ok[u]) m = m0; const int tok = m >> 2, h = m & 3;
            Yp[u] = (bf16*)(F.ws + (h < 2 ? WS_V01 : WS_V23)) + (size_t)tok * 1024 + (h & 1) * 512 + 8 * lane;
            yv[u] = *(const v4u*)Yp[u]; gv[u] = *(const v4u*)(GR + (size_t)tok * 2048 + h * 512 + 8 * lane);
            g0[u] = *(const f32x4*)(F.in[7] + h * 512 + 8 * lane); g1[u] = *(const f32x4*)(F.in[7] + h * 512 + 8 * lane + 4); }
#pragma unroll
        for (int u = 0; u < 2; ++u) {
            float y[8];
#pragma unroll
            for (int e = 0; e < 4; ++e) { y[2 * e] = bflo(yv[u][e]); y[2 * e + 1] = bfhi(yv[u][e]); }
            float ss = 0.f;
#pragma unroll
            for (int e = 0; e < 8; ++e) ss += y[e] * y[e];
            const float r = 1.f / sqrtf(wave_sum(ss) * (1.f / 512.f) + EPS);
            v4u o;
            o[0] = pk2(y[0] * r * g0[u][0] * bflo(gv[u][0]), y[1] * r * g0[u][1] * bfhi(gv[u][0])); o[1] = pk2(y[2] * r * g0[u][2] * bflo(gv[u][1]), y[3] * r * g0[u][3] * bfhi(gv[u][1]));
            o[2] = pk2(y[4] * r * g1[u][0] * bflo(gv[u][2]), y[5] * r * g1[u][1] * bfhi(gv[u][2])); o[3] = pk2(y[6] * r * g1[u][2] * bflo(gv[u][3]), y[7] * r * g1[u][3] * bfhi(gv[u][3]));
            if (ok[u]) { if (dummy) *(v4u*)((bf16*)(F.ws + WS_TMP) + (((size_t)(Yp[u] - (bf16*)F.ws)) & (size_t)0x3fffff)) = o; else *(v4u*)Yp[u] = o; }
        }
    }
}
struct AttnCur { int ti, kt; };
__device__ __forceinline__ void attn_advance(const Frame& F, AttnCur& c) {
    if (c.kt < 4) { c.kt += 1; } else { c.ti += 1; c.kt = attn_desc(F, c.ti).kt0; }
}
__device__ __forceinline__ void attention_phase2(Frame& F, bf16* O) {
    const bf16* QA = (const bf16*)(F.ws + WS_QA); const bf16* KA = (const bf16*)(F.ws + WS_KA); const bf16* VA = (const bf16*)(F.ws + WS_VA);
    const int lane = F.lane, r32 = lane & 31, hi = lane >> 5, wave = F.wave;
    LAS unsigned char* lds = F.lds + RING_OFF;
    LAS float* wsf = (LAS float*)(lds + AT_WSF) + wave * 128;
    LAS unsigned char* vb = lds + AT_VB + wave * 4096;
    LAS unsigned char* kb = lds + AT_KB + wave * 4096;
    const LAS unsigned char* krd = kb + r32 * 128;
    const int kxr = 16 * (hi ^ ((r32 >> 1) & 7));
    const LAS unsigned char* vrd = vb + ((lane >> 4) & 1) * 32 + (lane & 3) * 8 + (4 * hi + ((lane & 15) >> 2)) * 64;
    const int vkk = lane >> 3, vch = lane & 7;
    bf16x8 qa[4], qb[4];
    v4u k0[4], v0[4], k1[4], v1[4];
    bf16x8 qf[4]; float m = -1e30f, l = 0.f; f32x16 o0, o1;
#pragma unroll
    for (int i = 0; i < 16; ++i) { o0[i] = 0.f; o1[i] = 0.f; }
#define A2_ISSUE(C, KN, VN) do { const AttnTask X_ = attn_desc(F, (C).ti); if (X_.valid) { const size_t rowb_ = (size_t)X_.b * SEQ; const int iq0_ = X_.U0 / X_.r + 32 * X_.g, ik0_ = iq0_ - 128 + 32 * (C).kt; \
        _Pragma("unroll") for (int i_ = 0; i_ < 4; ++i_) KN[i_] = *(const v4u*)(KA + (rowb_ + X_.c + X_.r * (ik0_ + vkk + 8 * i_)) * 1024 + X_.h * 64 + 8 * vch); \
        _Pragma("unroll") for (int i_ = 0; i_ < 4; ++i_) VN[i_] = *(const v4u*)(VA + (rowb_ + X_.c + X_.r * (ik0_ + vkk + 8 * i_)) * 1024 + X_.h * 64 + 8 * vch); \
        if ((C).kt == X_.kt0) { const bf16* qp_ = QA + (rowb_ + X_.c + X_.r * (iq0_ + r32)) * 1024 + X_.h * 64 + 8 * hi; \
            if ((C).ti & 1) { _Pragma("unroll") for (int s = 0; s < 4; ++s) qb[s] = *(const bf16x8*)(qp_ + 16 * s); } \
            else { _Pragma("unroll") for (int s = 0; s < 4; ++s) qa[s] = *(const bf16x8*)(qp_ + 16 * s); } } } } while (0)
#define A2_STEP(KN, VN) do { \
        const AttnTask T = attn_desc(F, c0.ti); const int kt = c0.kt; \
        if (kt == T.kt0) { m = -1e30f; l = 0.f; \
            _Pragma("unroll") for (int i = 0; i < 16; ++i) { o0[i] = 0.f; o1[i] = 0.f; } \
            if (c0.ti & 1) { _Pragma("unroll") for (int s = 0; s < 4; ++s) qf[s] = qb[s]; } else { _Pragma("unroll") for (int s = 0; s < 4; ++s) qf[s] = qa[s]; } } \
        _Pragma("unroll") for (int i = 0; i < 4; ++i) *(LAS v4u*)(kb + (vkk + 8 * i) * 128 + 16 * (vch ^ (((vkk >> 1) + 4 * i) & 7))) = KN[i]; \
        _Pragma("unroll") for (int i = 0; i < 4; ++i) *(LAS v4u*)(vb + (vch >> 2) * 2048 + (vkk + 8 * i) * 64 + (vch & 3) * 16) = VN[i]; \
        A2_ISSUE(c2, KN, VN); \
        bf16x8 kf[4]; \
        _Pragma("unroll") for (int s = 0; s < 4; ++s) kf[s] = *(const LAS bf16x8*)(krd + ((32 * s) ^ kxr)); \
        f32x16 p; \
        _Pragma("unroll") for (int i = 0; i < 16; ++i) p[i] = 0.f; \
        _Pragma("unroll") for (int s = 0; s < 4; ++s) p = MFMA32(kf[s], qf[s], p); \
        if (kt == 0) { _Pragma("unroll") for (int i = 0; i < 16; ++i) if (crow(i, hi) < r32) p[i] = -INFINITY; } \
        if (kt == 4) { _Pragma("unroll") for (int i = 0; i < 16; ++i) if (crow(i, hi) > r32) p[i] = -INFINITY; } \
        float tm = p[0]; \
        _Pragma("unroll") for (int i = 1; i < 16; ++i) tm = fmaxf(tm, p[i]); \
        tm = half_max(tm); \
        const float mn = fmaxf(m, tm), corr = __builtin_amdgcn_exp2f(m - mn); \
        m = mn; float ps = 0.f; \
        _Pragma("unroll") for (int i = 0; i < 16; ++i) { p[i] = __builtin_amdgcn_exp2f(p[i] - mn); ps += p[i]; } \
        l = l * corr + ps; \
        if (hi == 0) wsf[r32] = corr; \
        const bf16x8 pa0 = pack8(p, 0), pa1 = pack8(p, 1); \
        _Pragma("unroll") for (int i = 0; i < 16; ++i) { const float f = wsf[crow(i, hi)]; o0[i] *= f; o1[i] *= f; } \
        _Pragma("unroll") for (int s = 0; s < 2; ++s) { \
            const s16x4 a0 = vtr(vrd + s * 1024), a1 = vtr(vrd + s * 1024 + 512), b0 = vtr(vrd + 2048 + s * 1024), b1 = vtr(vrd + 2048 + s * 1024 + 512); \
            const bf16x8 vv0 = (bf16x8){a0[0], a0[1], a0[2], a0[3], a1[0], a1[1], a1[2], a1[3]}, vv1 = (bf16x8){b0[0], b0[1], b0[2], b0[3], b1[0], b1[1], b1[2], b1[3]}; \
            o0 = MFMA32(s == 0 ? pa0 : pa1, vv0, o0); o1 = MFMA32(s == 0 ? pa0 : pa1, vv1, o1); } \
        if (kt == 4) {   \
            float lt = half_sum(l), mt = m; \
            LAS float* MS = (LAS float*)(lds + AT_MS); LAS float* LS = (LAS float*)(lds + AT_LS); \
            const int offq = T.c + T.r * (32 * T.g + r32); \
            float fa = 0.f, fb = 1.f / lt; \
            if (T.st != 0) { const float mo = MS[offq], lo = LS[offq]; \
                const float mm = fmaxf(mo, mt), wa = lo * __builtin_amdgcn_exp2f(mo - mm), wb = lt * __builtin_amdgcn_exp2f(mt - mm), ln = wa + wb; \
                fa = wa / ln; fb = (wb / ln) / lt; mt = mm; lt = ln; } \
            if (hi == 0) { MS[offq] = mt; LS[offq] = lt; wsf[r32] = fa; wsf[32 + r32] = fb; } \
            LAS unsigned short* OA = (LAS unsigned short*)(lds + AT_OACC); \
            if (T.st == 0) { \
                _Pragma("unroll") for (int i = 0; i < 16; ++i) { const int qq = crow(i, hi), off = T.c + T.r * (32 * T.g + qq); const float gb = wsf[32 + qq]; \
                    OA[off * 64 + r32] = (unsigned short)f2bf(gb * o0[i]); OA[off * 64 + 32 + r32] = (unsigned short)f2bf(gb * o1[i]); } \
            } else { \
                _Pragma("unroll") for (int i = 0; i < 16; ++i) { const int qq = crow(i, hi), off = T.c + T.r * (32 * T.g + qq); const float ga = wsf[qq], gb = wsf[32 + qq]; \
                    OA[off * 64 + r32] = (unsigned short)f2bf(gb * o0[i] + ga * bf2f(OA[off * 64 + r32])); OA[off * 64 + 32 + r32] = (unsigned short)f2bf(gb * o1[i] + ga * bf2f(OA[off * 64 + 32 + r32])); } \
            } \
            if (c0.ti & 1) {   \
                __syncthreads(); \
                if (T.st == 2) {   \
                    _Pragma("unroll") for (int it = 0; it < 8; ++it) { const int pi = it * 512 + F.tid, row = pi >> 3, ch = pi & 7; \
                        *(v4u*)(O + ((size_t)T.b * SEQ + T.U0 + row) * 1024 + T.h * 64 + ch * 8) = *(const LAS v4u*)(lds + AT_OACC + row * 128 + ch * 16); } \
                    __syncthreads(); } } } \
        c0 = c1; c1 = c2; attn_advance(F, c2); } while (0)
    AttnCur c0, c1, c2;
    c0.ti = 0; c0.kt = attn_desc(F, 0).kt0;
    c1 = c0; attn_advance(F, c1);
    c2 = c1; attn_advance(F, c2);
    A2_ISSUE(c0, k0, v0); A2_ISSUE(c1, k1, v1);
#pragma unroll 1
    while (attn_desc(F, c0.ti).valid) {
        A2_STEP(k0, v0);
        if (!attn_desc(F, c0.ti).valid) break;
        A2_STEP(k1, v1);
    }
#undef A2_ISSUE
#undef A2_STEP
}
#define OSWZ(row) (((row) ^ ((row) >> 2) ^ ((row) >> 4)) & 7)
#ifndef APF
#define APF 0
#endif
__device__ __forceinline__ void attention_phase3(Frame& F, bf16* O) {
    const bf16* QA = (const bf16*)(F.ws + WS_QA); const bf16* KA = (const bf16*)(F.ws + WS_KA); const bf16* VA = (const bf16*)(F.ws + WS_VA);
    const int lane = F.lane, r32_0 = lane & 31, hi_0 = lane >> 5, wave = F.wave;
    LAS unsigned char* lds = F.lds + RING_OFF;
    LAS float* wsf = (LAS float*)(lds + AT_WSF) + wave * 128;
    LAS unsigned char* vb = lds + AT_VB + wave * 4096;
    LAS unsigned char* kb = lds + AT_KB + wave * 4096;
    const int vkk0 = lane >> 3, vch0 = lane & 7;
    LAS float* MS = (LAS float*)(lds + AT_MS); LAS float* LS = (LAS float*)(lds + AT_LS);
    LAS unsigned short* OA = (LAS unsigned short*)(lds + AT_OACC);
    v4u kn[4], vn[4];
#define A3_LOAD(CC, IK0) do { \
        _Pragma("unroll") for (int i_ = 0; i_ < 4; ++i_) kn[i_] = *(const v4u*)(KA + (rowb + (CC) + r * ((IK0) + vkk + 8 * i_)) * 1024 + h * 64 + 8 * vch); \
        _Pragma("unroll") for (int i_ = 0; i_ < 4; ++i_) vn[i_] = *(const v4u*)(VA + (rowb + (CC) + r * ((IK0) + vkk + 8 * i_)) * 1024 + h * 64 + 8 * vch); } while (0)
#define A3_STORE() do { \
        _Pragma("unroll") for (int i = 0; i < 4; ++i) *(LAS v4u*)(kb + (vkk + 8 * i) * 128 + 16 * (vch ^ (((vkk >> 1) + 4 * i) & 7))) = kn[i]; \
        _Pragma("unroll") for (int i = 0; i < 4; ++i) *(LAS v4u*)(vb + (vch >> 2) * 2048 + (vkk + 8 * i) * 64 + (vch & 3) * 16) = vn[i]; } while (0)
#define A3_LOADQ(ST) do { const int r_ = (ST) == 0 ? 1 : ((ST) == 1 ? 4 : 16), npc_ = 16 / r_, tau_ = 2 * wave; \
        const int cA_ = tau_ / npc_, cB_ = (tau_ + 1) / npc_, iqA_ = U0 / r_ + 32 * (tau_ % npc_), iqB_ = U0 / r_ + 32 * ((tau_ + 1) % npc_); \
        int vkq_ = vkk0, vcq_ = vch0; LAUNDER(vkq_); LAUNDER(vcq_); \
        _Pragma("unroll") for (int i_ = 0; i_ < 4; ++i_) kn[i_] = *(const v4u*)(QA + (rowb + cA_ + r_ * (iqA_ + vkq_ + 8 * i_)) * 1024 + h * 64 + 8 * vcq_); \
        _Pragma("unroll") for (int i_ = 0; i_ < 4; ++i_) vn[i_] = *(const v4u*)(QA + (rowb + cB_ + r_ * (iqB_ + vkq_ + 8 * i_)) * 1024 + h * 64 + 8 * vcq_); } while (0)
#define A3_QFRAG(SRC, QF) do { \
        _Pragma("unroll") for (int i = 0; i < 4; ++i) *(LAS v4u*)(kb + (vkk + 8 * i) * 128 + 16 * (vch ^ (((vkk >> 1) + 4 * i) & 7))) = SRC[i]; \
        _Pragma("unroll") for (int s = 0; s < 4; ++s) QF[s] = *(const LAS bf16x8*)(krd + ((32 * s) ^ kxr)); } while (0)
#define A3_ROLE(QF, MM, LL, O0, O1, TREL) do { \
        f32x16 p; \
        _Pragma("unroll") for (int i = 0; i < 16; ++i) p[i] = 0.f; \
        _Pragma("unroll") for (int s = 0; s < 4; ++s) { const bf16x8 kf_ = *(const LAS bf16x8*)(krd + ((32 * s) ^ kxr)); p = MFMA32(kf_, QF[s], p); } \
        if ((TREL) == 0) { asm volatile("");     \
            _Pragma("unroll") for (int i = 0; i < 16; ++i) if (crow(i, hi) < r32) p[i] = -INFINITY; } \
        if ((TREL) == 4) { asm volatile(""); _Pragma("unroll") for (int i = 0; i < 16; ++i) if (crow(i, hi) > r32) p[i] = -INFINITY; } \
        float tm = p[0]; \
        _Pragma("unroll") for (int i = 1; i < 16; ++i) tm = fmaxf(tm, p[i]); \
        tm = half_max(tm); \
        const float mn = fmaxf(MM, tm), corr = __builtin_amdgcn_exp2f(MM - mn); \
        MM = mn; float ps = 0.f; \
        _Pragma("unroll") for (int i = 0; i < 16; ++i) { p[i] = __builtin_amdgcn_exp2f(p[i] - mn); ps += p[i]; } \
        LL = LL * corr + ps; \
        const bf16x8 pa0 = pack8(p, 0), pa1 = pack8(p, 1); \
        _Pragma("unroll") for (int i = 0; i < 16; ++i) { O0[i] *= corr; O1[i] *= corr; }     \
        _Pragma("unroll") for (int s = 0; s < 2; ++s) { \
            const s16x4 a0 = vtr(vrd + s * 1024), a1 = vtr(vrd + s * 1024 + 512), b0 = vtr(vrd + 2048 + s * 1024), b1 = vtr(vrd + 2048 + s * 1024 + 512); \
            const bf16x8 vv0 = (bf16x8){a0[0], a0[1], a0[2], a0[3], a1[0], a1[1], a1[2], a1[3]}, vv1 = (bf16x8){b0[0], b0[1], b0[2], b0[3], b1[0], b1[1], b1[2], b1[3]}; \
            O0 = MFMA32(vv0, s == 0 ? pa0 : pa1, O0); O1 = MFMA32(vv1, s == 0 ? pa0 : pa1, O1); } } while (0)
#define A3_MERGE(MM, LL, O0, O1, CC, GG) do { \
        float lt = half_sum(LL), mt = MM; \
        const int offq = (CC) + r * (32 * (GG) + r32); \
        float fa = 0.f, fb = 1.f / lt; \
        if (st != 0) { const float mo = MS[offq], lo = LS[offq]; \
            const float mm = fmaxf(mo, mt), wa = lo * __builtin_amdgcn_exp2f(mo - mm), wb = lt * __builtin_amdgcn_exp2f(mt - mm), ln = wa + wb; \
            fa = wa / ln; fb = (wb / ln) / lt; mt = mm; lt = ln; } \
        if (hi == 0) { MS[offq] = mt; LS[offq] = lt; } \
          \
        LAS unsigned* orow = (LAS unsigned*)(lds + AT_OACC + offq * 128); const int osw = 16 * OSWZ(offq); \
        if (st == 0) { \
            _Pragma("unroll") for (int i = 0; i < 16; i += 2) { const int d2 = 2 * crow(i, hi); \
                orow[(d2 ^ osw) >> 2] = pk2(fb * O0[i], fb * O0[i + 1]); orow[((64 + d2) ^ osw) >> 2] = pk2(fb * O1[i], fb * O1[i + 1]); } \
        } else { \
            _Pragma("unroll") for (int i = 0; i < 16; i += 2) { const int d2 = 2 * crow(i, hi); \
                const unsigned o0 = orow[(d2 ^ osw) >> 2], o1 = orow[((64 + d2) ^ osw) >> 2]; \
                orow[(d2 ^ osw) >> 2] = pk2(fb * O0[i] + fa * bflo(o0), fb * O0[i + 1] + fa * bfhi(o0)); orow[((64 + d2) ^ osw) >> 2] = pk2(fb * O1[i] + fa * bflo(o1), fb * O1[i + 1] + fa * bfhi(o1)); } \
        } } while (0)
    const unsigned pfbase = __builtin_amdgcn_readfirstlane((unsigned)(size_t)F.lds + RING_OFF + 140288 + 256 * wave);
#define A3_PF(PB, PH, RLO, RHI) do { const int lo_ = (RLO) < 0 ? 0 : (RLO), hi_ = (RHI) < 0 ? 0 : (RHI); \
        for (int i_ = F.tid; i_ < 2 * (hi_ - lo_); i_ += NWAVES * 64) { const bf16* p_ = ((i_ & 1) ? VA : KA) + ((size_t)(PB) * SEQ + lo_ + (i_ >> 1)) * 1024 + (PH) * 64; \
            unsigned sv_; asm volatile("s_mov_b32 %0, m0\n\ts_mov_b32 m0, %2\n\ts_nop 0\n\tglobal_load_lds_dword %1, off\n\ts_mov_b32 m0, %0" : "=&s"(sv_) : "v"(p_), "s"(pfbase)); } } while (0)
    for (int idx = F.vcu; idx < 512; idx += F.G) {
        const int rnd = idx >> 8, v8 = idx & 255, bh = 64 * rnd + (v8 >> 2), G = rnd == 0 ? (v8 & 3) : 3 - (v8 & 3);
        const int b = bh >> 4, h = bh & 15, U0 = 512 * G;
        const size_t rowb = (size_t)b * SEQ;
        A3_LOADQ(0);
#pragma unroll 1
        for (int st = 0; st < 3; ++st) {
#if APF
            if (st == 0) A3_PF(b, h, U0 - 512, U0 - 128);
            else if (st == 1) A3_PF(b, h, U0 - 2048, U0 - 512);
            else { const int nidx = idx + F.G; if (nidx < 512) { const int nr = nidx >> 8, n8 = nidx & 255, nbh = 64 * nr + (n8 >> 2), nG = nr == 0 ? (n8 & 3) : 3 - (n8 & 3); A3_PF(nbh >> 4, nbh & 15, 512 * nG - 128, 512 * nG + 512); } }
#endif
            int vkk = vkk0, vch = vch0, r32 = r32_0, hi = hi_0; LAUNDER(vkk); LAUNDER(vch); LAUNDER(r32); LAUNDER(hi);
            const int r32g = r32, hig = hi;
            const LAS unsigned char* krd = kb + r32 * 128;
            const int kxr = 16 * (hi ^ ((r32 >> 1) & 7));
            const LAS unsigned char* vrd = vb + (((r32 >> 4) & 1) * 32 + (r32 & 3) * 8 + (4 * hi + ((r32 & 15) >> 2)) * 64);
            const int r = st == 0 ? 1 : (st == 1 ? 4 : 16), npc = 16 / r;
            const int tauA = 2 * wave, cA = tauA / npc, gA = tauA % npc, cB = (tauA + 1) / npc, gB = (tauA + 1) % npc;
            const int iqA0 = U0 / r + 32 * gA, iqB0 = U0 / r + 32 * gB;
            bf16x8 qfA[4], qfB[4];
            A3_QFRAG(kn, qfA); A3_QFRAG(vn, qfB);
            float mA = -1e30f, lA = 0.f, mB = -1e30f, lB = 0.f;
            f32x16 oA0, oA1, oB0, oB1;
#pragma unroll
            for (int i = 0; i < 16; ++i) { oA0[i] = 0.f; oA1[i] = 0.f; oB0[i] = 0.f; oB1[i] = 0.f; }
            int ktA0 = 4 - (iqA0 >> 5); if (ktA0 < 0) ktA0 = 0;
            if (st != 2) {
                A3_LOAD(cA, iqA0 - 128 + 32 * ktA0);
#pragma unroll 1
                for (int t = ktA0; t <= 5; ++t) {
                    A3_STORE();
                    if (t < 5) A3_LOAD(cA, iqA0 - 128 + 32 * (t + 1));
                    if (t <= 4) A3_ROLE(qfA, mA, lA, oA0, oA1, t);
                    __builtin_amdgcn_sched_barrier(0);
                    if (t >= 1) A3_ROLE(qfB, mB, lB, oB0, oB1, t - 1);
                }
            } else {
                int ktB0 = 4 - (iqB0 >> 5); if (ktB0 < 0) ktB0 = 0;
                A3_LOAD(cA, iqA0 - 128 + 32 * ktA0);
#pragma unroll 1
                for (int t = ktA0; t <= 4; ++t) {
                    A3_STORE();
                    if (t < 4) A3_LOAD(cA, iqA0 - 128 + 32 * (t + 1)); else A3_LOAD(cB, iqB0 - 128 + 32 * ktB0);
                    A3_ROLE(qfA, mA, lA, oA0, oA1, t);
                }
#pragma unroll 1
                for (int t = ktB0; t <= 4; ++t) {
                    A3_STORE();
                    if (t < 4) A3_LOAD(cB, iqB0 - 128 + 32 * (t + 1));
                    A3_ROLE(qfB, mB, lB, oB0, oB1, t);
                }
            }
            if (st == 0) A3_LOADQ(1); else if (st == 1) A3_LOADQ(2);
            A3_MERGE(mA, lA, oA0, oA1, cA, gA);
            A3_MERGE(mB, lB, oB0, oB1, cB, gB);
            __syncthreads();
        }
        int tidw = F.tid; LAUNDER(tidw);
#pragma unroll
        for (int it = 0; it < 8; ++it) { const int pi = it * 512 + tidw, row = pi >> 3, ch = pi & 7;
            *(v4u*)(O + ((size_t)b * SEQ + U0 + row) * 1024 + h * 64 + ch * 8) = *(const LAS v4u*)(lds + AT_OACC + row * 128 + 16 * (ch ^ OSWZ(row))); }
        __syncthreads();
    }
#undef A3_LOAD
#undef A3_PF
#undef A3_LOADQ
#undef A3_QFRAG
#undef A3_STORE
#undef A3_ROLE
#undef A3_MERGE
}
#ifndef FLOW_SIG
#define FLOW_SIG 0
#endif
#ifndef FLOW_WAIT
#define FLOW_WAIT 0
#endif
__device__ __forceinline__ void p5_router(Frame& F, const bool dummy) {
    LAS float* scr = (LAS float*)(F.lds + RING_OFF + F.wave * 16384);
    const int gw = F.vcu * NWAVES + F.wave, NGW = F.G * NWAVES, lane = F.lane;
    bf16* W13 = (bf16*)(F.ws + WS_W13);
    constexpr int I_13 = (D / 64) * (FF / 32);
    constexpr int NITEMS = NE * (2 * I_13);
#ifndef RTABL
#define RTABL 0
#endif
    const int rabl = dummy ? RTABL : 0;
    for (int it = gw; it < ((rabl & 1) ? 0 : NITEMS); it += NGW) {
        const int e = it / (2 * I_13); int r = it - e * (2 * I_13);
        { const int w3 = r >= I_13; if (w3) r -= I_13; const int nblk = FF / 32, kb = r / nblk, nb = r % nblk, n0 = 32 * nb;
            const int prow = (n0 >> 7) * 256 + w3 * 128 + (n0 & 127);
            transpose_item(F.in[w3 ? 16 : 15] + (size_t)e * D * FF, FF, 64 * kb, n0, W13 + (size_t)e * 512 * D, D, prow, 0, scr, lane); }
    }
    __syncthreads();
    LAS float* WT = (LAS float*)(F.lds + RING_OFF);
    for (int q = F.tid; q < D * 36; q += NWAVES * 64) { const int p = q / 36, c = q - p * 36, k = (p & ~63) + 4 * (p & 15) + ((p >> 4) & 3);
        WT[q] = F.in[10][k] * (c < 4 ? F.in[11][k * 4 + c] : F.in[13][k * 32 + (c - 4)]); }
    __syncthreads();
    const float* X1 = F.out; bf16* X1N = (bf16*)(F.ws + WS_X1N); const float* gff = F.in[10];
    const float* brg = F.in[12]; const float* bre = F.in[14];
    unsigned* cnt = F.ctl + CW_CNT + (dummy ? 32 : 0);     int* LIST = (int*)(F.ws + (dummy ? 230 * MiB : WS_LIST)); float* GATE = (float*)(F.ws + (dummy ? 234 * MiB : WS_GATE));
    const int kl = lane & 15, tg = lane >> 4;
#define DPP_ADD(v, ctrl) v += __builtin_bit_cast(float, __builtin_amdgcn_update_dpp(0, __builtin_bit_cast(int, v), ctrl, 0xf, 0xf, false))
#define ROW16_SUM(v) do { DPP_ADD(v, 0xB1); DPP_ADD(v, 0x4E); DPP_ADD(v, 0x141); DPP_ADD(v, 0x140); } while (0)
    for (int m4 = gw; m4 < ((rabl & 2) ? 0 : M / 4); m4 += NGW) {
        const int m = 4 * m4 + tg;
        int klg = kl; asm volatile("" : "+v"(klg));
        const f32x4* xr = (const f32x4*)(X1 + (size_t)m * D) + kl;
        float s = 0.f;
        f32x4 a[9];
#pragma unroll
        for (int c = 0; c < 9; ++c) a[c] = (f32x4){0.f, 0.f, 0.f, 0.f};
#pragma unroll 1
        for (int j4 = 0; j4 < 4; ++j4) {
            f32x4 x[4];
#pragma unroll
            for (int jj = 0; jj < 4; ++jj) { x[jj] = xr[16 * (4 * j4 + jj)]; s += (x[jj][0] * x[jj][0] + x[jj][1] * x[jj][1]) + (x[jj][2] * x[jj][2] + x[jj][3] * x[jj][3]); }
#pragma unroll
            for (int jj = 0; jj < 4; ++jj)
#pragma unroll
                for (int e = 0; e < 4; ++e) {
                    const LAS f32x4* wr = (const LAS f32x4*)(WT + (64 * (4 * j4 + jj) + 16 * e + kl) * 36);
                    const float xv = x[jj][e];
#pragma unroll
                    for (int c = 0; c < 9; ++c) a[c] += wr[c] * xv;
                    if (e & 1) __builtin_amdgcn_sched_barrier(0);
                }
            __builtin_amdgcn_sched_barrier(0);
        }
        ROW16_SUM(s);
        const float rinv = 1.f / sqrtf(s * (1.f / D) + EPS);
        v2u* xo = (v2u*)(X1N + (size_t)m * D) + kl;
#pragma unroll
        for (int j = 0; j < 16; ++j) {
            const f32x4 xx = xr[16 * j], gg = *((const f32x4*)gff + 16 * j + klg);
            v2u o; o[0] = pk2(xx[0] * rinv * gg[0], xx[1] * rinv * gg[1]); o[1] = pk2(xx[2] * rinv * gg[2], xx[3] * rinv * gg[3]);
            xo[16 * j] = o;
        }
        float lgt[36];
#pragma unroll
        for (int c = 0; c < 9; ++c)
#pragma unroll
            for (int e = 0; e < 4; ++e) { float t = a[c][e]; ROW16_SUM(t); lgt[4 * c + e] = t * rinv + (4 * c + e < 4 ? brg[4 * c + e] : bre[4 * c + e - 4]); }
        int g = 0; float gm = lgt[0];
#pragma unroll
        for (int j = 1; j < 4; ++j) if (lgt[j] > gm) { gm = lgt[j]; g = j; }
        float den = 0.f;
#pragma unroll
        for (int j = 0; j < 4; ++j) den += __expf(lgt[j] - gm);
        const float pg = 1.f / den;
        float v1 = -INFINITY, v2 = -INFINITY; int i1 = 0, i2 = 0;
#pragma unroll
        for (int j = 0; j < 8; ++j) { const float xx = g == 0 ? lgt[4 + j] : (g == 1 ? lgt[12 + j] : (g == 2 ? lgt[20 + j] : lgt[28 + j]));
            if (xx > v1) { v2 = v1; i2 = i1; v1 = xx; i1 = j; } else if (xx > v2) { v2 = xx; i2 = j; } }
        const float e2 = __expf(v2 - v1), w1 = pg / (1.f + e2), w2 = pg * e2 / (1.f + e2);
        if (kl == 0) {
            const int l1 = 8 * g + i1, l2 = 32 + 8 * g + i2;
            const unsigned p1 = __hip_atomic_fetch_add(cnt + 64 * l1, 1u, RLX_AGENT), p2 = __hip_atomic_fetch_add(cnt + 64 * l2, 1u, RLX_AGENT);
            LIST[(size_t)l1 * M + p1] = m; GATE[(size_t)l1 * M + p1] = w1;
            LIST[(size_t)l2 * M + p2] = m; GATE[(size_t)l2 * M + p2] = w2;
            if (!dummy) {
                const int ilo = i1 < i2 ? i1 : i2, ihi = i1 < i2 ? i2 : i1, q = 28 * g + ((ilo * (15 - ilo)) >> 1) + (ihi - ilo - 1);
                const unsigned pp = __hip_atomic_fetch_add(F.ctl + CW_PCNT + 64 * q, 1u, RLX_AGENT);
                const unsigned en1 = ((unsigned)l1 << 14) | p1, en2 = ((unsigned)l2 << 14) | p2;
                ((int*)(F.ws + WS_PTOK))[(size_t)q * M + pp] = m; ((unsigned*)(F.ws + WS_PLO))[(size_t)q * M + pp] = i1 < i2 ? en1 : en2; ((unsigned*)(F.ws + WS_PHI))[(size_t)q * M + pp] = i1 < i2 ? en2 : en1;
            }
        }
        asm volatile("" ::: "memory");
    }
#undef DPP_ADD
#undef ROW16_SUM
}

__device__ __forceinline__ int moe_list_of_pos(int o) { return (o >> 1) | ((o & 1) << 5); }
__device__ __forceinline__ int moe_pos_of_list(int l) { return ((l & 31) << 1) | (l >> 5); }
__device__ __forceinline__ void moe_tile_table(Frame& F) {
    LAS int* tp = (LAS int*)(F.lds + LDS_TP_OFF); LAS int* tmp = (LAS int*)(F.lds + LDS_PTP_OFF + 512);
    __syncthreads();
    if (F.tid < 64) tmp[F.tid] = (int)((__hip_atomic_load(F.ctl + CW_CNT + 64 * moe_list_of_pos(F.tid), RLX_AGENT) + 255u) >> 8);
    __syncthreads();
    if (F.tid == 0) { int acc = 0; for (int o = 0; o < 64; ++o) { tp[o] = acc; acc += tmp[o]; } tp[64] = acc; }
    __syncthreads();
}
__device__ __forceinline__ int moe_heavy(int ntile, int G) { const int maxT = (ntile + G - 1) / G; const int rem = ntile - (maxT - 1) * G; return (ntile == 0 || rem >= G) ? 0 : rem; }
__device__ __forceinline__ void moe_pair_table(Frame& F) {
    LAS int* ptp = (LAS int*)(F.lds + LDS_PTP_OFF); LAS int* tmp = ptp + 128;
    __syncthreads();
    if (F.tid < 112) tmp[F.tid] = (int)((__hip_atomic_load(F.ctl + CW_PCNT + 64 * F.tid, RLX_AGENT) + 255u) >> 8);
    __syncthreads();
    if (F.tid == 0) { int acc = 0; for (int q = 0; q < 112; ++q) { ptp[q] = acc; acc += tmp[q]; } ptp[112] = acc; }
    __syncthreads();
}
__device__ __forceinline__ void moe_w2_convert(Frame& F) {
    const LAS int* tp = (const LAS int*)(F.lds + LDS_TP_OFF);
    const int G = F.G, rem = moe_heavy(2 * tp[64], G);
    if (F.vcu < rem) return;
    LAS float* scr = (LAS float*)(F.lds + RING_OFF + F.wave * 16384);
    bf16* W2T = (bf16*)(F.ws + WS_W2);
    constexpr int I_2 = (FF / 64) * (D / 32);
    for (int it = (F.vcu - rem) * NWAVES + F.wave; it < NE * I_2; it += (G - rem) * NWAVES) {
        const int e = it / I_2, r = it - e * I_2, nblk = D / 32, kb = r / nblk, nb = r % nblk;
        transpose_item<FLOW_SIG != 0>(F.in[17] + (size_t)e * FF * D, D, 64 * kb, 32 * nb, W2T + (size_t)e * D * FF, FF, 32 * nb, 0, scr, F.lane); }
    asm volatile("s_waitcnt vmcnt(0)" ::: "memory"); __syncthreads();
    if (F.tid == 0) { (void)__hip_atomic_fetch_add(F.ctl + CW_W2D, 1u, RLX_AGENT); }
}
struct SchedUp {
    const LAS int* tp; const int* LIST; const unsigned* cnt; const char* X; const char* W13; int G, c;
    __device__ __forceinline__ int rowof(int raw) const { return raw & 16383; }
    __device__ bool next(int i, Unit& u) const {
        const int L = i * G + c, tile = L >> 1, ct = L & 1; if (tile >= tp[64]) return false;
        int lo = 0, hi = 64; while (hi - lo > 1) { const int mid = (lo + hi) >> 1; if (tp[mid] <= tile) lo = mid; else hi = mid; }
        const int rt = tile - tp[lo], l = moe_list_of_pos(lo), e = l & 31;
        u.A = X; u.B = W13 + ((size_t)e * 512 + 256 * ct) * D * 2; u.rows = LIST + (size_t)l * M + rt * 256; u.nt = 16; u.pm = tile; u.pn = ct; u.part = l; u.aux = rt; u.fin = true; return true;
    }
};
struct EpiUp {
    static constexpr bool PERM = true; static constexpr bool SIGNAL = (FLOW_SIG != 0);
    bf16* H; const float* GATE; unsigned* upc;
    __device__ __forceinline__ void signal(const Unit& u) const { (void)__hip_atomic_fetch_add(upc + 64 * u.part, 1u, RLX_AGENT); (void)__hip_atomic_fetch_add(upc + 64 * 64 + 64, 1u, RLX_AGENT); }
    __device__ __forceinline__ void operator()(AccRef acc, const Unit& u, int wr, int wc, int fr, int fq) const {
        const int row0 = u.pm * 256 + wr * 64 + fr, col0 = 128 * u.pn + 32 * wc + 8 * fq;
        const float* gp = GATE + (size_t)u.part * M + u.aux * 256 + wr * 64 + fr;
#pragma unroll
        for (int ai = 0; ai < 2; ++ai)
#pragma unroll
            for (int m = 0; m < 4; ++m) { v4u w; const float g = gp[ai * 128 + m * 16];
#pragma unroll
                for (int n = 0; n < 2; ++n) { const pg8::f32x4 a = acc[ai][0][m][n], b = acc[ai][1][m][n]; pg8::f32x4 h;
#pragma unroll
                    for (int e = 0; e < 4; ++e) h[e] = a[e] * sigmoidf_(a[e]) * (b[e] * g);
                    w[2 * n] = pg8::cvt_pk_bf16(h[0], h[1]); w[2 * n + 1] = pg8::cvt_pk_bf16(h[2], h[3]); }
                { void* hp_ = (void*)(H + (size_t)(row0 + ai * 128 + m * 16) * FF + col0);
#if FLOW_SIG
                  asm volatile("global_store_dwordx4 %0, %1, off sc1\n\ts_nop 1" :: "v"(hp_), "v"(w) : "memory");
#else
                  *(v4u*)hp_ = w;
#endif
                } }
    }
};
struct SchedDownP {
    const LAS int* ptp; const LAS int* tp; const int* PLO; const char* H; const char* W2; unsigned* ctl; int G, c, ntv, nconv; mutable bool alldone;
    __device__ __forceinline__ int rowof(int raw) const { return (tp[moe_pos_of_list((raw >> 14) & 63)] * 256 + (raw & 16383)) & 65535; }
    __device__ bool next(int i, Unit& u) const {
        const int ti = i >> 1, part = i & 1, L = ti * G + c, tile = L >> 2, ct = L & 3; if (tile >= ptp[112]) return false;
        int lo = 0, hi = 112; while (hi - lo > 1) { const int mid = (lo + hi) >> 1; if (ptp[mid] <= tile) lo = mid; else hi = mid; }
        const int q = lo, rt = tile - ptp[q], g = q / 28; int t = q - 28 * g, a = 0; while (t >= 7 - a) { t -= 7 - a; ++a; }
        const int ea = 8 * g + a, eb = 8 * g + a + 1 + t;
        if (FLOW_WAIT && part == 0 && !alldone) {
            unsigned need[4]; unsigned* pc[4];
#pragma unroll
            for (int k = 0; k < 4; ++k) { const int l = ((k & 1) ? eb : ea) + 32 * (k >> 1), o = moe_pos_of_list(l); pc[k] = ctl + CW_UPC + 64 * l; need[k] = 2u * (unsigned)(tp[o + 1] - tp[o]); }
            const unsigned nup = 2u * (unsigned)tp[64];
            for (unsigned sp = 0;; ++sp) {
                const unsigned w2 = __hip_atomic_load(ctl + CW_W2D, RLX_AGENT), ua = __hip_atomic_load(ctl + CW_W2D + 64, RLX_AGENT);
                const unsigned c0 = __hip_atomic_load(pc[0], RLX_AGENT), c1 = __hip_atomic_load(pc[1], RLX_AGENT), c2 = __hip_atomic_load(pc[2], RLX_AGENT), c3 = __hip_atomic_load(pc[3], RLX_AGENT);
                if (w2 >= (unsigned)nconv && ua >= nup) { alldone = true; break; }
                if (w2 >= (unsigned)nconv && c0 >= need[0] && c1 >= need[1] && c2 >= need[2] && c3 >= need[3]) break;
                if (sp > (1u << 18)) break;
                __builtin_amdgcn_s_sleep(2);
            }
            __builtin_amdgcn_fence(__ATOMIC_ACQUIRE, "agent");
        }
        const int e = part ? eb : ea;
        u.A = H; u.B = W2 + ((size_t)e * D + 256 * ct) * FF * 2; u.rows = PLO + (part ? (size_t)((WS_PHI - WS_PLO) / 4) : (size_t)0) + (size_t)q * M + rt * 256;
        u.nt = ntv; u.pm = tile; u.pn = ct; u.part = q; u.aux = rt; u.fin = (part != 0); return true;
    }
};
struct EpiDownP {
    static constexpr bool PERM = false; static constexpr bool SIGNAL = false;
    const int* PTOK; const unsigned* pcnt; float* O;
    __device__ __forceinline__ void operator()(AccRef acc, const Unit& u, int wr, int wc, int fr, int fq) const {
        const int q = u.part, n_q = (int)pcnt[64 * q];
        const int r0 = u.aux * 256 + wr * 64 + fr, col0 = u.pn * 256 + wc * 32 + 4 * fq;
        const int* lp = PTOK + (size_t)q * M + r0;
#pragma unroll
        for (int ai = 0; ai < 2; ++ai)
#pragma unroll
            for (int m = 0; m < 4; ++m) { const int rr = ai * 128 + m * 16;
                if (r0 + rr < n_q) { float* op = O + (size_t)(unsigned)lp[rr] * D + col0;
#pragma unroll
                    for (int bj = 0; bj < 2; ++bj)
#pragma unroll
                        for (int n = 0; n < 2; ++n) { const f32x4 xs = *(const f32x4*)(op + bj * 128 + n * 16); *(f32x4*)(op + bj * 128 + n * 16) = xs + acc[ai][bj][m][n]; } }
                asm volatile("" ::: "memory"); }
    }
};
struct Args { const float* in[18]; float* out; unsigned char* ws; int ph_lo, ph_hi, aux0, pad; };
enum { PH_PRO = 0, PH_G1A, PH_ATT, PH_G1B, PH_RET, PH_G1C, PH_MIX, PH_OUT, PH_RTR, PH_UP, PH_DN1, PH_DN2, PH_END, PH_RETS = 20, PH_RETC = 21 };

__device__ __forceinline__ bool frame_relane(Frame& F) { int t = threadIdx.x; asm volatile("" : "+v"(t)); F.tid = t; F.lane = t & 63; return true; }
#ifndef OUT_PF
#define OUT_PF 0
#endif
__device__ __forceinline__ void l2_prefetch_tile(const Frame& F, int pm, int pn, const float* X) {
    const unsigned pfb = __builtin_amdgcn_readfirstlane((unsigned)(size_t)F.lds + 131072 + 256 * F.wave);
    const float* p = X + (size_t)(pm * 256 + (F.tid >> 3)) * D + pn * 256 + 32 * (F.tid & 7);
#pragma unroll 1
    for (int k = 0; k < 4; ++k) { asm volatile("s_mov_b32 m0, %1\n\ts_nop 0\n\tglobal_load_lds_dword %0, off" :: "v"(p), "s"(pfb) : "m0", "memory"); p += (size_t)64 * D; }
}
__global__ void __launch_bounds__(NWAVES * 64, 2) fwd(Args args) {
    extern __shared__ __attribute__((aligned(16))) unsigned char lds[];
    Frame F;
    F.lds = (LAS unsigned char*)lds;
    F.MISC = (volatile LAS unsigned*)(F.lds + MISC_OFF);
    F.tid = threadIdx.x; F.lane = F.tid & 63; F.wave = __builtin_amdgcn_readfirstlane(F.tid >> 6);
    F.G = gridDim.x; { const int bx = blockIdx.x; F.vcu = (F.G % 8 == 0) ? (bx % 8) * (F.G / 8) + bx / 8 : bx; }
    F.ws = args.ws; F.ctl = (unsigned*)(args.ws + WS_CTL); F.out = args.out;
    F.in = args.in;
    for (int u = F.tid; u < (LDS_BYTES - LDSCTL_OFF) / 4; u += NWAVES * 64) ((LAS unsigned*)(F.lds + LDSCTL_OFF))[u] = 0u;
    __syncthreads();
    const int lo = args.ph_lo, hi = args.ph_hi;
    const bool multi = (hi - lo) > 1;
    XcdBarrier bar; bar.bar = F.ctl + CW_BAR; bar.x = 0; bar.st = nullptr;
    if (multi) bar = xcd_barrier_post(F.ctl + CW_BAR, F.MISC + 8);
#ifndef ATT2
#define ATT2 3
#endif
#ifndef DUP_NULL
#define DUP_NULL 0
#endif
#ifndef PROJ_ALIGN
#define PROJ_ALIGN true
#endif
#ifndef DUP_MASK
#define DUP_MASK 0u
#endif
#ifndef PHMASK
#define PHMASK 0xffffffu
#endif
#define IN(k) (((PHMASK >> ((k) > 12 ? 12 : (k))) & 1u) && lo <= (k) && (k) < hi && frame_relane(F))
#define SEAM(k) do { if (IN((k) + 1)) xcd_barrier(bar); } while (0)
    unsigned char* ws = args.ws;
    bf16* GRb = (bf16*)args.out; bf16* GAb = (bf16*)args.out; bf16* GBb = (bf16*)args.out + (size_t)M * 1024;

    if (IN(PH_PRO)) { p0_prologue(F); if ((DUP_MASK >> PH_PRO) & 1u) { __syncthreads(); p0_prologue(F); } SEAM(PH_PRO); }

#define PROJ_PHASE(PH, TILE0, NTILES) if (IN(PH)) { \
        SchedPlain S; S.T.init(M, (NTILES) * 256, F.G, (int)blockIdx.x); S.A = (const char*)(ws + WS_XN); S.B = (const char*)(ws + WS_WIN); S.lda = D; S.ldb = D; S.nt = D / 64; S.pn0 = (TILE0); \
        EpiProj E{ws, (bf16*)args.out, F.in}; \
        if ((DUP_MASK >> (PH)) & 1u) { if (DUP_NULL == 1) { EpiNull EN_; pg8::gemm_phase<EpiNull, SchedPlain, false>(F.lds + RING_OFF, D, D, S, EN_); } else if (DUP_NULL == 2) { EpiStoreOnly ES_{(bf16*)(ws + WS_QR)}; pg8::gemm_phase<EpiStoreOnly, SchedPlain, false>(F.lds + RING_OFF, D, D, S, ES_); } else if (DUP_NULL == 4) { EpiNull EN_; SchedConstAB SC_{S}; pg8::gemm_phase<EpiNull, SchedConstAB, false>(F.lds + RING_OFF, D, D, SC_, EN_); } else if (DUP_NULL == 3) { pg8::gemm_phase<EpiProj, SchedPlain, false, PROJ_ALIGN>(F.lds + RING_OFF, D, D, S, E); } else pg8::gemm_phase<EpiProj, SchedPlain, false, PROJ_ALIGN>(F.lds + RING_OFF, D, D, S, E); } \
        pg8::gemm_phase<EpiProj, SchedPlain, false, PROJ_ALIGN>(F.lds + RING_OFF, D, D, S, E); SEAM(PH); }
    PROJ_PHASE(PH_G1A, 0, 12)
    if (IN(PH_ATT)) {
#if ATT_SIMPLE
        attn_simple(F);
#else
        if (DUP_MASK & (1u << PH_ATT)) { attention_phase(F, (bf16*)F.out, AABL); __syncthreads(); }
#if ATT2 == 3
        attention_phase3(F, (bf16*)(F.ws + WS_QA));
#elif ATT2
        attention_phase2(F, (bf16*)(F.ws + WS_QA));
#else
        attention_phase(F, (bf16*)(F.ws + WS_QA), 0);
#endif
#endif
        SEAM(PH_ATT); }
    PROJ_PHASE(PH_G1B, 12, 24)
    if (IN(PH_RET)) {
#if RET_SIMPLE
        for (int n = 15; n >= 0; --n) { ret_simple_chunk(F, n); if (multi) xcd_barrier(bar); ret_simple_copy(F, n); if (multi && n > 0) xcd_barrier(bar); }
#else
        if (DUP_MASK & (1u << PH_RET)) { retention_phase(F, true); __syncthreads(); }
        retention_phase(F, false);
#endif
        SEAM(PH_RET); }
    if (IN(PH_RETS)) { ret_simple_chunk(F, args.aux0); }
    if (IN(PH_RETC)) { ret_simple_copy(F, args.aux0); }
#if !RET_SIMPLE
    if (IN(PH_G1C)) { if (DUP_MASK & (1u << 15)) { retnorm_pass(F, true); __syncthreads(); } retnorm_pass(F); }
#endif
    PROJ_PHASE(PH_G1C, 36, 8)

    if (IN(PH_MIX)) {
        SchedMix S; S.T.init(M, D, F.G, (int)blockIdx.x); S.ATT = (const char*)(ws + WS_QA); S.W = (const char*)(ws + WS_WMIX);
        EpiMix E{GAb, GBb, (bf16*)(ws + WS_M32), (bf16*)(ws + WS_MRG)};
        pg8::gemm_phase<EpiMix, SchedMix, false>(F.lds + RING_OFF, D, 3072, S, E); if ((DUP_MASK >> PH_MIX) & 1u) pg8::gemm_phase<EpiMix, SchedMix, false>(F.lds + RING_OFF, D, 3072, S, E); SEAM(PH_MIX);
    }
    if (IN(PH_OUT)) {
        SchedPlain S; S.T.init(M, D, F.G, (int)blockIdx.x); S.A = (const char*)(ws + WS_MRG); S.B = (const char*)(ws + WS_WOUT); S.lda = D; S.ldb = D; S.nt = D / 64; S.pn0 = 0;
        EpiOut E{F.in[0], F.out};
        { pg8::TileOrder T2_; T2_.init(M, D, F.G, (int)blockIdx.x); int pm_ = 0, pn_ = 0; const bool ok_ = T2_.tile(0, pm_, pn_); if (OUT_PF && ok_) l2_prefetch_tile(F, pm_, pn_, args.in[0]); }
        pg8::gemm_phase<EpiOut, SchedPlain, false>(F.lds + RING_OFF, D, D, S, E); if ((DUP_MASK >> PH_OUT) & 1u) pg8::gemm_phase<EpiOut, SchedPlain, false>(F.lds + RING_OFF, D, D, S, E); SEAM(PH_OUT);
    }
    if (IN(PH_RTR)) { if ((DUP_MASK >> PH_RTR) & 1u) { p5_router(F, true); __syncthreads(); } p5_router(F, false); SEAM(PH_RTR); }
#ifndef FLOW_SEAM
#define FLOW_SEAM SEAM(PH_UP);
#endif
    if (IN(PH_UP)) {
        moe_tile_table(F);
        SchedUp S{(const LAS int*)(F.lds + LDS_TP_OFF), (const int*)(ws + WS_LIST), F.ctl + CW_CNT, (const char*)(ws + WS_X1N), (const char*)(ws + WS_W13), F.G, F.vcu};
        EpiUp E{(bf16*)(ws + WS_H), (const float*)(ws + WS_GATE), F.ctl + CW_UPC};
        pg8::gemm_phase<EpiUp, SchedUp, true>(F.lds + RING_OFF, D, D, S, E);
        __syncthreads(); moe_w2_convert(F); FLOW_SEAM
    }
    if (IN(PH_DN1)) {
        moe_tile_table(F); moe_pair_table(F);
        int nt4 = 4; asm volatile("" : "+s"(nt4));
        const LAS int* tp = (const LAS int*)(F.lds + LDS_TP_OFF);
        const int heavy = moe_heavy(2 * tp[64], F.G);
        SchedDownP S{(const LAS int*)(F.lds + LDS_PTP_OFF), tp, (const int*)(ws + WS_PLO), (const char*)(ws + WS_H), (const char*)(ws + WS_W2), F.ctl, F.G, (F.vcu - heavy + F.G) % F.G, nt4, F.G - heavy, false};
        EpiDownP E{(const int*)(ws + WS_PTOK), F.ctl + CW_PCNT, F.out};
        pg8::gemm_phase<EpiDownP, SchedDownP, true>(F.lds + RING_OFF, FF, FF, S, E);
    }
#ifdef EXTRA_BARS
    if (multi) for (int i_ = 0; i_ < EXTRA_BARS; ++i_) xcd_barrier(bar);
#endif
#ifdef EXTRA_BARS
    if (multi) for (int i_ = 0; i_ < EXTRA_BARS; ++i_) xcd_barrier(bar);
#endif
#undef IN
#undef SEAM
}

extern "C" void kernel_launch(void* const* d_in, const int* in_sizes, int n_in, void* d_out, int out_size, void* d_ws, size_t ws_size, hipStream_t stream) {
    static int grid = 0;
    if (grid == 0) {
        if (n_in != 18 || in_sizes[0] != M * D || out_size != M * D || ws_size < WS_END) { fprintf(stderr, "kernel_launch: unexpected problem shape (n_in %d, in0 %d, out %d, ws %zu)\n", n_in, n_in > 0 ? in_sizes[0] : -1, out_size, ws_size); grid = -1; return; }
        int dev = 0, cus = 0, per_cu = 0;
        if (hipGetDevice(&dev) != hipSuccess || hipDeviceGetAttribute(&cus, hipDeviceAttributeMultiprocessorCount, dev) != hipSuccess) { grid = -1; return; }
        if (hipFuncSetAttribute((const void*)fwd, hipFuncAttributeMaxDynamicSharedMemorySize, LDS_BYTES) != hipSuccess) { fprintf(stderr, "kernel_launch: hipFuncSetAttribute failed\n"); grid = -1; return; }
        if (hipOccupancyMaxActiveBlocksPerMultiprocessor(&per_cu, (const void*)fwd, NWAVES * 64, LDS_BYTES) != hipSuccess || per_cu < 1) { fprintf(stderr, "kernel_launch: occupancy query says %d blocks per CU\n", per_cu); }
        (void)hipGetLastError();
        grid = cus;
    }
    if (grid < 0) return;
    (void)hipMemsetAsync((char*)d_ws + WS_CTL, 0, CTL_ZERO_BYTES, stream);
    Args a{};
    for (int i = 0; i < 18; ++i) a.in[i] = (const float*)d_in[i];
    a.out = (float*)d_out; a.ws = (unsigned char*)d_ws;
#define LAUNCH(LO, HI, AUX) do { a.ph_lo = (LO); a.ph_hi = (HI); a.aux0 = (AUX); hipLaunchKernelGGL(fwd, dim3(grid), dim3(NWAVES * 64), LDS_BYTES, stream, a); } while (0)
#ifndef DBG_LAST
#define DBG_LAST 99
#endif
#if MK_MODE == 0
    for (int ph = PH_PRO; ph <= PH_G1B && ph <= DBG_LAST; ++ph) LAUNCH(ph, ph + 1, 0);
    if (DBG_LAST >= PH_RET) for (int n = 15; n >= 0; --n) { LAUNCH(PH_RETS, PH_RETS + 1, n); LAUNCH(PH_RETC, PH_RETC + 1, n); }
    for (int ph = PH_G1C; ph < PH_END && ph <= DBG_LAST; ++ph) LAUNCH(ph, ph + 1, 0);
#else
    LAUNCH(PH_PRO, PH_END, 0);
#endif
}
```

```cpp
#include <hip/hip_runtime.h>
#include <cstdio>
#include <cstdint>

#define GAS __attribute__((address_space(1)))
#define LAS __attribute__((address_space(3)))
typedef unsigned short bf16;
typedef unsigned v4u __attribute__((ext_vector_type(4)));
typedef unsigned v2u __attribute__((ext_vector_type(2)));
typedef float f32x4 __attribute__((ext_vector_type(4)));
typedef float f32x2 __attribute__((ext_vector_type(2)));
typedef short bf16x8 __attribute__((ext_vector_type(8)));
typedef GAS unsigned gu32;
#define RLX_AGENT __ATOMIC_RELAXED, __HIP_MEMORY_SCOPE_AGENT
#define LDS_WAIT() asm volatile("s_waitcnt lgkmcnt(0)" ::: "memory")
#define VM_WAIT() asm volatile("s_waitcnt vmcnt(0)" ::: "memory")

__device__ __forceinline__ unsigned pk2(float lo, float hi) { unsigned r; asm volatile("v_cvt_pk_bf16_f32 %0, %1, %2" : "=v"(r) : "v"(lo), "v"(hi)); return r; }
__device__ __forceinline__ unsigned f2bf(float f) { return pk2(f, 0.f) & 0xffffu; }
__device__ __forceinline__ float bf2f(unsigned short h) { return __builtin_bit_cast(float, (unsigned)h << 16); }
__device__ __forceinline__ float bflo(unsigned w) { return __builtin_bit_cast(float, w << 16); }
__device__ __forceinline__ float bfhi(unsigned w) { return __builtin_bit_cast(float, w & 0xffff0000u); }
__device__ __forceinline__ float wave_sum(float v) {
#define WS_DPP(ctrl) v += __builtin_bit_cast(float, __builtin_amdgcn_update_dpp(0, __builtin_bit_cast(int, v), ctrl, 0xf, 0xf, false))
    WS_DPP(0xB1); WS_DPP(0x4E); WS_DPP(0x141); WS_DPP(0x140);
#undef WS_DPP
    const int iv = __builtin_bit_cast(int, v);
    return (__builtin_bit_cast(float, __builtin_amdgcn_readlane(iv, 0)) + __builtin_bit_cast(float, __builtin_amdgcn_readlane(iv, 16))) + (__builtin_bit_cast(float, __builtin_amdgcn_readlane(iv, 32)) + __builtin_bit_cast(float, __builtin_amdgcn_readlane(iv, 48)));
}

constexpr int NB = 8, SEQ = 2048, D = 1024, M = NB * SEQ;
constexpr int AH = 16, AHD = 64;
constexpr int RH = 4, RDK = 256, RDV = 512, RCH = 128;
constexpr int NIN = 11264;
constexpr int NG = 4, EPG = 8, NE = 32, FF = 256;
constexpr float EPS = 1e-6f;
constexpr float C2 = 0.125f * 1.4426950408889634f;

constexpr size_t MiB = 1u << 20;
constexpr size_t WS_CTL = 0, CTL_ZERO_BYTES = 256 * 1024;
constexpr size_t WS_SS = 512 * 1024;
constexpr size_t WS_COSA = 1 * MiB, WS_SINA = WS_COSA + 256 * 1024, WS_COSR = WS_SINA + 256 * 1024, WS_SINR = WS_COSR + 1 * MiB;
constexpr size_t WS_WIN = 4 * MiB;
constexpr size_t WS_WMIX = 26 * MiB;
constexpr size_t WS_WOUT = 32 * MiB;
constexpr size_t WS_XN = 34 * MiB;
constexpr size_t WS_QA = 66 * MiB;
constexpr size_t WS_KA = 98 * MiB, WS_VA = 130 * MiB;
constexpr size_t WS_QR = 98 * MiB, WS_KR = 130 * MiB;
constexpr size_t WS_V01 = 162 * MiB, WS_V23 = 194 * MiB;
constexpr size_t WS_M32 = 98 * MiB;
constexpr size_t WS_MRG = 34 * MiB;
constexpr size_t WS_TMP = 226 * MiB;
constexpr size_t WS_X1N = 34 * MiB;
constexpr size_t WS_W13 = 66 * MiB;
constexpr size_t WS_W2 = 130 * MiB;
constexpr size_t WS_H = 146 * MiB;
constexpr int HROWS = 49152;
constexpr size_t WS_LIST = 170 * MiB;
constexpr size_t WS_GATE = 174 * MiB;
constexpr size_t WS_PTOK = 178 * MiB;
constexpr size_t WS_PLO = 186 * MiB;
constexpr size_t WS_PHI = 194 * MiB;
constexpr size_t WS_END = 242 * MiB;
constexpr int CW_BAR = 4096;
constexpr int CW_CNT = 16384;
constexpr int CW_PCNT = CW_CNT + 64 * 64;
constexpr int CW_UPC = CW_PCNT + 64 * 112;
constexpr int CW_W2D = CW_UPC + 64 * 64;
static_assert((CW_W2D + 128) * 4 <= (int)CTL_ZERO_BYTES, "ctl");

constexpr int RING_OFF = 0, RING_BYTES = 131072;
constexpr int LDSCTL_OFF = 148480, MISC_OFF = LDSCTL_OFF + 320;
constexpr int LDS_TP_OFF = MISC_OFF + 128;
constexpr int LDS_PTP_OFF = 150016;
constexpr int LDS_BYTES = 155648;
static_assert(LDS_TP_OFF + 66 * 4 <= LDS_BYTES, "LDS map");
constexpr int NWAVES = 8;
#define MK_MODE 1
#define ATT_SIMPLE 0
#define RET_SIMPLE 0
#ifndef RET_SIMPLE
#define RET_SIMPLE 1
#endif
#ifndef ATT_SIMPLE
#define ATT_SIMPLE 1
#endif
namespace pg8 {
#define PG8_LAS __attribute__((address_space(3)))
typedef unsigned short bf16_t;
typedef short bf16x8 __attribute__((ext_vector_type(8)));
typedef float f32x4 __attribute__((ext_vector_type(4)));
typedef unsigned u32x4 __attribute__((ext_vector_type(4)));
constexpr int BM = 256, BK = 64, HALF = 128, HTB = HALF * BK * 2  , STAGE_BYTES = 8 * HTB, NXCD = 8, WGM = 8;

__host__ __device__ __forceinline__ int lds_byte(int r, int c) { const int st = (r >> 4) * 2 + (c >> 5), rr = r & 15, cc = c & 31, ob = rr * 64 + cc * 2; return st * 1024 + (ob ^ (((ob >> 9) & 1) << 5)); }
__host__ __device__ __forceinline__ void stage_rc(int b, int& R, int& C) { const int st = b / 1024, sb = b % 1024, swz = sb ^ (((sb >> 9) & 1) << 5); R = (st >> 1) * 16 + swz / 64; C = (st & 1) * 32 + (swz % 64) / 2; }
__host__ __device__ __forceinline__ int perm32(int rho) { const int n = rho >> 4, i = rho & 15; return 8 * (i >> 2) + 4 * n + (i & 3); }

struct Unit { const char* A; const char* B; const int* rows; int nt; int pm, pn, part, aux; bool fin; };

#ifndef TILE_ROT
#define TILE_ROT 1
#endif
struct TileOrder {
    int nM, nN, nwg, G, c;
    __device__ void init(int M, int N, int G_, int c_) { nM = M / BM; nN = N / BM; nwg = nM * nN; G = G_; c = c_; }
    __device__ __forceinline__ bool tile(int i, int& pm, int& pn) const {
        const long L = (long)i * G + c; if (L >= nwg) return false;
        int wgid = (int)L; { const int q = nwg / NXCD, r = nwg % NXCD, xcd = wgid % NXCD, off = wgid / NXCD; wgid = (xcd < r ? xcd * (q + 1) : r * (q + 1) + (xcd - r) * q) + off; }
        const int nig = WGM * nN, gid = wgid / nig, fm = gid * WGM, gsz = (nM - fm) < WGM ? (nM - fm) : WGM;
        int w = wgid % nig;
        if (TILE_ROT && gsz == WGM) w = (w + (gid & 7) * (nig / 8)) % nig;
        pm = fm + (w % gsz); pn = w / gsz; return true;
    }
};

__device__ __forceinline__ unsigned cvt_pk_bf16(float lo, float hi) { unsigned r; asm volatile("v_cvt_pk_bf16_f32 %0, %1, %2" : "=v"(r) : "v"(lo), "v"(hi)); return r; }

template <class Epi, class Sched, bool GATHER, bool ALIGN_EPI = true>
__device__ __forceinline__ void gemm_phase(PG8_LAS unsigned char* lds, const int lda, const int ldb, const Sched& S, const Epi& E) {
    const int tid = threadIdx.x, wid = __builtin_amdgcn_readfirstlane(tid >> 6), lane = tid & 63, wr = wid >> 2, wc = wid & 3, fr = lane & 15, fq = lane >> 4;
    unsigned voffA[GATHER ? 2 : 1][2], voffB[2]; int RA[2], CA[2];
#pragma unroll
    for (int i = 0; i < 2; ++i) { int R, C; stage_rc(tid * 16 + i * 8192, R, C); const int Rb = Epi::PERM ? ((R & ~31) + perm32(R & 31)) : R;
        RA[i] = R; CA[i] = C;
        voffA[0][i] = (unsigned)(R * lda + C) * 2u; voffB[i] = (unsigned)(Rb * ldb + C) * 2u; }
    const size_t kstep = (size_t)(BK * 2);
    const size_t hstepB = (size_t)HALF * ldb * 2;
    const size_t hstepA = GATHER ? (size_t)0 : (size_t)HALF * lda * 2;
    const unsigned ldsw = (unsigned)wid * 1024u;
    const int aoff = lds_byte(wr * 64 + fr, fq * 8), boff = lds_byte(wc * 32 + fr, fq * 8);
#define PG8_SA(b, h) (((b) * 2 + (h)) * HTB)
#define PG8_SB(b, h) ((4 + (b) * 2 + (h)) * HTB)
#define PG8_STAGE(bufoff, gbase, voff) do { _Pragma("unroll") for (int _i = 0; _i < 2; ++_i) \
        __builtin_amdgcn_global_load_lds((const unsigned*)((const char*)(gbase) + (voff)[_i]), (PG8_LAS unsigned*)(lds + (bufoff) + ldsw + _i * 8192), 16, 0, 0); } while (0)
#define PG8_LDA(dst, b, h) do { _Pragma("unroll") for (int m = 0; m < 4; ++m) _Pragma("unroll") for (int k = 0; k < 2; ++k) dst[m][k] = *(const PG8_LAS bf16x8*)(lds + PG8_SA(b, h) + aoff + m * 2048 + k * 1024); } while (0)
#define PG8_LDB(dst, b, h) do { _Pragma("unroll") for (int n = 0; n < 2; ++n) _Pragma("unroll") for (int k = 0; k < 2; ++k) dst[n][k] = *(const PG8_LAS bf16x8*)(lds + PG8_SB(b, h) + boff + n * 2048 + k * 1024); } while (0)
#define PG8_MMA(ai, bj, At, Bt) do { __builtin_amdgcn_s_setprio(1); _Pragma("unroll") for (int m = 0; m < 4; ++m) _Pragma("unroll") for (int n = 0; n < 2; ++n) _Pragma("unroll") for (int k = 0; k < 2; ++k) \
        acc[ai][bj][m][n] = __builtin_amdgcn_mfma_f32_16x16x32_bf16(Bt[n][k], At[m][k], acc[ai][bj][m][n], 0, 0, 0); __builtin_amdgcn_s_setprio(0); } while (0)
#define PG8_WAIT_V(n) asm volatile("s_waitcnt vmcnt(" #n ")" ::: "memory")
#define PG8_WAIT_L(n) asm volatile("s_waitcnt lgkmcnt(" #n ")" ::: "memory")
#define PG8_BAR __builtin_amdgcn_s_barrier()
#define PG8_SCHED __builtin_amdgcn_sched_barrier(0)
#define PG8_GATHER_OFFS(U, dst) do { if constexpr (GATHER) { _Pragma("unroll") for (int _h = 0; _h < 2; ++_h) _Pragma("unroll") for (int _i = 0; _i < 2; ++_i) \
        dst[_h][_i] = (unsigned)(S.rowof((U).rows[_h * HALF + RA[_i]]) * lda + CA[_i]) * 2u; } } while (0)
    Unit cur, nxt; int ui = 0;
    if (!S.next(0, cur)) return;
    f32x4 acc[2][2][4][2];
#pragma unroll
    for (int a = 0; a < 2; ++a)
#pragma unroll
        for (int b = 0; b < 2; ++b)
#pragma unroll
            for (int m = 0; m < 4; ++m)
#pragma unroll
                for (int n = 0; n < 2; ++n) acc[a][b][m][n] = (f32x4){0.f, 0.f, 0.f, 0.f};
    bf16x8 At[4][2], B0[2][2], B1[2][2];
    const char* cA = cur.A; const char* cB = cur.B;
    PG8_GATHER_OFFS(cur, voffA);
    PG8_STAGE(PG8_SB(0, 0), cB, voffB); PG8_STAGE(PG8_SB(0, 1), cB + hstepB, voffB); PG8_STAGE(PG8_SA(0, 0), cA, voffA[0]); PG8_STAGE(PG8_SA(0, 1), cA + hstepA, voffA[GATHER ? 1 : 0]);
    if (wr == 1) PG8_BAR;
    PG8_WAIT_V(2); PG8_BAR;
    PG8_STAGE(PG8_SB(1, 0), cB + kstep, voffB); PG8_STAGE(PG8_SA(1, 0), cA + kstep, voffA[0]); PG8_STAGE(PG8_SB(1, 1), cB + hstepB + kstep, voffB);
    PG8_WAIT_V(6); PG8_BAR;
    for (;;) {
        const bool has_next = S.next(ui + 1, nxt);
        const char* nA = has_next ? nxt.A : cA; const char* nB = has_next ? nxt.B : cB;
        const int nt = cur.nt;
        for (int t = 0; t < nt; t += 2) {
            const bool last = (t == nt - 2);
            const char* a1 = cA + (size_t)(t + 1) * kstep;
            const char* a2 = last ? nA : cA + (size_t)(t + 2) * kstep; const char* b2 = last ? nB : cB + (size_t)(t + 2) * kstep;
            const char* a3 = a2 + kstep; const char* b3 = b2 + kstep;
            PG8_LDB(B0, 0, 0); PG8_LDB(B1, 0, 1); PG8_SCHED; PG8_LDA(At, 0, 0); PG8_STAGE(PG8_SA(1, 1), a1 + hstepA, voffA[GATHER ? 1 : 0]);
            if constexpr (GATHER) { if (last && has_next) { PG8_GATHER_OFFS(nxt, voffA); } }
            PG8_WAIT_V(8); PG8_WAIT_L(0); PG8_BAR; PG8_MMA(0, 0, At, B0); PG8_MMA(0, 1, At, B1); PG8_BAR; PG8_SCHED;
            PG8_LDA(At, 0, 1); PG8_STAGE(PG8_SB(0, 0), b2, voffB); PG8_STAGE(PG8_SB(0, 1), b2 + hstepB, voffB); PG8_STAGE(PG8_SA(0, 0), a2, voffA[0]);
            PG8_WAIT_V(8); PG8_WAIT_L(0); PG8_BAR; PG8_MMA(1, 0, At, B0); PG8_MMA(1, 1, At, B1); PG8_BAR; PG8_SCHED;
            PG8_LDB(B0, 1, 0); PG8_LDB(B1, 1, 1); PG8_SCHED; PG8_LDA(At, 1, 0); PG8_STAGE(PG8_SA(0, 1), a2 + hstepA, voffA[GATHER ? 1 : 0]);
            PG8_WAIT_V(8); PG8_WAIT_L(0); PG8_BAR; PG8_MMA(0, 0, At, B0); PG8_MMA(0, 1, At, B1); PG8_BAR; PG8_SCHED;
            PG8_LDA(At, 1, 1); PG8_STAGE(PG8_SB(1, 0), b3, voffB); PG8_STAGE(PG8_SB(1, 1), b3 + hstepB, voffB); PG8_STAGE(PG8_SA(1, 0), a3, voffA[0]);
            PG8_WAIT_V(8); PG8_WAIT_L(0); PG8_BAR; PG8_MMA(1, 0, At, B0); PG8_MMA(1, 1, At, B1); PG8_BAR; PG8_SCHED;
        }
        if constexpr (ALIGN_EPI) { if (wr == 0) PG8_BAR; }
        if (cur.fin) {
            E(acc, cur, wr, wc, fr, fq);
            if constexpr (Epi::SIGNAL) {
                static_assert(ALIGN_EPI, "the signal barrier needs both wave halves aligned");
                asm volatile("s_waitcnt vmcnt(0)" ::: "memory"); PG8_BAR; if (tid == 0) E.signal(cur); }
#pragma unroll
            for (int a = 0; a < 2; ++a)
#pragma unroll
                for (int b = 0; b < 2; ++b)
#pragma unroll
                    for (int m = 0; m < 4; ++m)
#pragma unroll
                        for (int n = 0; n < 2; ++n) acc[a][b][m][n] = (f32x4){0.f, 0.f, 0.f, 0.f};
        }
        if (!has_next) break;
        cur = nxt; cA = nA; cB = nB; ++ui;
        if constexpr (ALIGN_EPI) { if (wr == 1) PG8_BAR; }
    }
    PG8_WAIT_V(0);
    if constexpr (!ALIGN_EPI) { if (wr == 0) PG8_BAR; }
    PG8_BAR;
#undef PG8_SA
#undef PG8_SB
#undef PG8_STAGE
#undef PG8_LDA
#undef PG8_LDB
#undef PG8_MMA
#undef PG8_WAIT_V
#undef PG8_WAIT_L
#undef PG8_BAR
#undef PG8_SCHED
#undef PG8_GATHER_OFFS
}
}
#define XB_TMO      128
#define XB_XCNT(j)  (256  + 64 * (j))
#define XB_XSUB(j)  (1280 + 64 * (j))
#define XB_XGEN(j)  (2304 + 64 * (j))
#define XB_TOP      3328
#define XB_TOPGEN   3392
#define XCD_BAR_WORDS 3456
#define XB_SPIN_CAP (1u << 18)

__device__ __forceinline__ unsigned xb_ld(unsigned* p)              { return __hip_atomic_load(p, __ATOMIC_RELAXED, __HIP_MEMORY_SCOPE_AGENT); }
__device__ __forceinline__ unsigned xb_add(unsigned* p, unsigned v) { return __hip_atomic_fetch_add(p, v, __ATOMIC_RELAXED, __HIP_MEMORY_SCOPE_AGENT); }
__device__ __forceinline__ unsigned xb_xcc_id() { return (unsigned)__builtin_amdgcn_s_getreg((3 << 11) | 20) & 0xFu; }
#define XB_SPIN(cond, bar) do { unsigned _sp = 0; while (cond) { __builtin_amdgcn_s_sleep(1); \
    if ((++_sp & 255u) == 0u) { if (xb_ld(&(bar)[XB_TMO])) break; if (_sp > XB_SPIN_CAP) { atomicAdd(&(bar)[XB_TMO], 1u); break; } } } } while (0)

struct XcdBarrier { unsigned* bar; unsigned x; volatile LAS unsigned* st; };

__device__ __forceinline__ XcdBarrier xcd_barrier_post(unsigned* bar, volatile LAS unsigned* st) {
    XcdBarrier b; b.bar = bar; b.x = xb_xcc_id(); b.st = st;
    if (threadIdx.x == 0) (void)xb_add(&bar[XB_XCNT(b.x)], 1u);
    return b;
}
__device__ __forceinline__ void xcd_barrier_complete(unsigned* bar, unsigned x, unsigned& nloc, unsigned& nx) {
    const unsigned G = gridDim.x * gridDim.y * gridDim.z;
    unsigned sum, cnt, mine, sp = 0u;
    for (;;) {
        sum = 0u; cnt = 0u; mine = 0u;
#pragma unroll
        for (unsigned j = 0; j < 16; ++j) { const unsigned c = xb_ld(&bar[XB_XCNT(j)]); sum += c; cnt += (c > 0u) ? 1u : 0u; mine = (j == x) ? c : mine; }
        if (sum == G) break;
        __builtin_amdgcn_s_sleep(1);
        if ((++sp & 255u) == 0u) { if (xb_ld(&bar[XB_TMO])) break; if (sp > XB_SPIN_CAP) { atomicAdd(&bar[XB_TMO], 1u); break; } }
    }
    nloc = mine > 0u ? mine : 1u; nx = cnt > 0u ? cnt : 1u;
}
__device__ __forceinline__ void xcd_barrier(const XcdBarrier& b) {
    asm volatile("s_waitcnt vmcnt(0)" ::: "memory");
    __syncthreads();
    if (threadIdx.x == 0) {
        unsigned* bar = b.bar;
        __builtin_amdgcn_s_waitcnt(0);
        unsigned nloc = b.st[0], nx = b.st[1];
        if (nloc == 0u) { xcd_barrier_complete(bar, b.x, nloc, nx); b.st[0] = nloc; b.st[1] = nx; }
        const unsigned old = xb_add(&bar[XB_XSUB(b.x)], 1u);
        const unsigned gen = old / nloc;
        if (old + 1u == (gen + 1u) * nloc) {
            __builtin_amdgcn_fence(__ATOMIC_RELEASE, "agent");
            asm volatile("s_waitcnt vmcnt(0)" ::: "memory");
            const unsigned og = xb_add(&bar[XB_TOP], 1u);
            const unsigned tg = og / nx;
            if (og + 1u == (tg + 1u) * nx) xb_add(&bar[XB_TOPGEN], 1u);
            else XB_SPIN(xb_ld(&bar[XB_TOPGEN]) == tg, bar);
            __builtin_amdgcn_fence(__ATOMIC_ACQUIRE, "agent");
            xb_add(&bar[XB_XGEN(b.x)], 1u);
            asm volatile("s_waitcnt vmcnt(0)" ::: "memory");
        } else {
            XB_SPIN(xb_ld(&bar[XB_XGEN(b.x)]) == gen, bar);
            __builtin_amdgcn_fence(__ATOMIC_ACQUIRE, "agent");
            asm volatile("s_waitcnt vmcnt(0)" ::: "memory");
        }
    }
    __syncthreads();
}

#define XB_LSUB(j)  (3456 + 64 * (j))
#define XB_BAD      (3456 + 64 * 16)
#define XB_ARR      (3456 + 64 * 17)
#define XB_ARR2     (3456 + 64 * 18)
#define XB_ARR3     (3456 + 64 * 19)
__device__ __forceinline__ void xcd_barrier_local(const XcdBarrier& b, const unsigned nloc) {
    asm volatile("s_waitcnt vmcnt(0)" ::: "memory");
    __syncthreads();
    if (threadIdx.x == 0) {
        unsigned* bar = b.bar;
        const unsigned old = xb_add(&bar[XB_LSUB(b.x)], 1u), tgt = (old / nloc + 1u) * nloc;
        XB_SPIN(xb_ld(&bar[XB_LSUB(b.x)]) < tgt, bar);
        __builtin_amdgcn_fence(__ATOMIC_ACQUIRE, "agent");
        asm volatile("s_waitcnt vmcnt(0)" ::: "memory");
    }
    __syncthreads();
}

struct Frame {
    LAS unsigned char* lds;
    volatile LAS unsigned* MISC;
    unsigned* ctl;
    unsigned char* ws;
    int tid, lane, wave;
    int vcu, G;
    const float* const* in;
    float* out;
};

template <bool WT = false>
__device__ __forceinline__ void transpose_item(const float* W, int N, int k0, int lc0, bf16* WT_, int ldt, int pr0, int koff, LAS float* scr, int lane) {
    {
        f32x4 t[8]; const int rr = lane >> 3, cc = 4 * (lane & 7);
#pragma unroll
        for (int i = 0; i < 8; ++i) t[i] = *(const f32x4*)(W + (size_t)(k0 + 8 * i + rr) * N + lc0 + cc);
#pragma unroll
        for (int i = 0; i < 8; ++i) { LAS float* d = scr + (8 * i + rr) * 33 + cc; d[0] = t[i][0]; d[1] = t[i][1]; d[2] = t[i][2]; d[3] = t[i][3]; }
    }
    LDS_WAIT(); asm volatile("" ::: "memory");
    const int c = lane & 7;
#pragma unroll
    for (int j = 0; j < 4; ++j) { const int n = (lane >> 3) + 8 * j; const LAS float* s = scr + (8 * c) * 33 + n;
        v4u o; o.x = pk2(s[0 * 33], s[1 * 33]); o.y = pk2(s[2 * 33], s[3 * 33]); o.z = pk2(s[4 * 33], s[5 * 33]); o.w = pk2(s[6 * 33], s[7 * 33]);
        if constexpr (WT) { void* p_ = (void*)(WT_ + (size_t)(pr0 + n) * ldt + koff + k0 + 8 * c); asm volatile("global_store_dwordx4 %0, %1, off sc1\n\ts_nop 1" :: "v"(p_), "v"(o) : "memory"); }
        else *(GAS v4u*)(WT_ + (size_t)(pr0 + n) * ldt + koff + k0 + 8 * c) = o; }
    LDS_WAIT(); asm volatile("" ::: "memory");
}
__device__ __forceinline__ void rms_row_to_bf16(const float* xrow, const float* g, bf16* orow, int lane) {
    const GAS f32x4* xr = (const GAS f32x4*)xrow + lane; const GAS f32x4* gr = (const GAS f32x4*)g + lane;
    f32x4 v[4]; float s = 0.f;
#pragma unroll
    for (int j = 0; j < 4; ++j) { v[j] = xr[64 * j]; s += (v[j].x * v[j].x + v[j].y * v[j].y) + (v[j].z * v[j].z + v[j].w * v[j].w); }
    const float rinv = 1.f / sqrtf(wave_sum(s) * (1.f / D) + EPS);
    GAS unsigned long long* o8 = (GAS unsigned long long*)orow + lane;
#pragma unroll
    for (int j = 0; j < 4; ++j) { const f32x4 gg = gr[64 * j];
        o8[64 * j] = (unsigned long long)pk2(v[j].x * rinv * gg.x, v[j].y * rinv * gg.y) | ((unsigned long long)pk2(v[j].z * rinv * gg.z, v[j].w * rinv * gg.w) << 32); }
}
__device__ __forceinline__ int win_logical(int p) {
    if (p >= 2048) return p;
    const int t = p >> 8, q = p & 255, bj = q >> 7, wc = (q >> 5) & 3, j = q & 31;
    return t * 256 + 64 * wc + 32 * bj + j;
}
#ifndef P0_DEFER
#define P0_DEFER 1
#endif
template <bool WT = false>
__device__ __forceinline__ void p0_weights(Frame& F, const int part) {
    LAS float* scr = (LAS float*)(F.lds + RING_OFF + F.wave * 16384);
    const int gw = F.vcu * NWAVES + F.wave, NGW = F.G * NWAVES;
    bf16* WinT = (bf16*)(F.ws + WS_WIN); bf16* WmixT = (bf16*)(F.ws + WS_WMIX); bf16* WoutT = (bf16*)(F.ws + WS_WOUT);
    constexpr int I_IN = (D / 64) * (NIN / 32), I_ATT = (D / 64) * (D / 32), I_RET = (2048 / 64) * (D / 32), I_OUT = (D / 64) * (D / 32);
    constexpr int NITEMS = I_IN + I_ATT + I_RET + I_OUT;
    constexpr int I_EARLY = (D / 64) * 96;
    constexpr int I_MID = (D / 64) * 288;
    const int lo = part == 2 ? I_EARLY : (part == 3 ? I_MID : 0), hi = part == 1 ? I_EARLY : (part == 2 ? I_MID : NITEMS);
    for (int it = lo + gw; it < hi; it += NGW) {
        int r = hi - 1 - (it - lo);
        if (r < I_IN) { const int kb = r & 15, nb = r >> 4; transpose_item<WT>(F.in[2], NIN, 64 * kb, win_logical(32 * nb), WinT, D, 32 * nb, 0, scr, F.lane); continue; } r -= I_IN;
        if (r < I_ATT) { const int nblk = D / 32, kb = r / nblk, nb = r % nblk; transpose_item<WT>(F.in[6], D, 64 * kb, 32 * nb, WmixT, 3072, 32 * nb, 0, scr, F.lane); continue; } r -= I_ATT;
        if (r < I_RET) { const int nblk = D / 32, kb = r / nblk, nb = r % nblk; transpose_item<WT>(F.in[8], D, 64 * kb, 32 * nb, WmixT, 3072, 32 * nb, 1024, scr, F.lane); continue; } r -= I_RET;
        { const int nblk = D / 32, kb = r / nblk, nb = r % nblk; transpose_item<WT>(F.in[9], D, 64 * kb, 32 * nb, WoutT, D, 32 * nb, 0, scr, F.lane); }
    }
}
__device__ __forceinline__ void p0_prologue(Frame& F) {
    LAS float* scr = (LAS float*)(F.lds + RING_OFF + F.wave * 16384);
    const int gw = F.vcu * NWAVES + F.wave, NGW = F.G * NWAVES;
    bf16* WinT = (bf16*)(F.ws + WS_WIN); bf16* WmixT = (bf16*)(F.ws + WS_WMIX); bf16* WoutT = (bf16*)(F.ws + WS_WOUT);
    constexpr int I_IN = (D / 64) * (NIN / 32), I_ATT = (D / 64) * (D / 32), I_RET = (2048 / 64) * (D / 32), I_OUT = (D / 64) * (D / 32);
    constexpr int NITEMS = I_IN + I_ATT + I_RET + I_OUT;
    p0_weights<true>(F, P0_DEFER ? 1 : 0);
    const int gt = (F.vcu * NWAVES + F.wave) * 64 + F.lane, NGT = F.G * NWAVES * 64;
    float* cosa = (float*)(F.ws + WS_COSA); float* sina = (float*)(F.ws + WS_SINA);
    for (int i = gt; i < SEQ * 32; i += NGT) { const int pos = i >> 5, d = i & 31; const double inv = exp2(-(double)(2 * d) / 64.0 * 13.287712379549449); double s, c; sincos((double)pos * inv, &s, &c);
        const float cf = (float)c, sf = (float)s; asm volatile("global_store_dword %0, %1, off sc1\n\tglobal_store_dword %2, %3, off sc1" :: "v"(cosa + i), "v"(cf), "v"(sina + i), "v"(sf) : "memory"); }
    asm volatile("s_waitcnt vmcnt(0)" ::: "memory");
    __syncthreads();
    if (F.tid == 0) (void)xb_add(F.ctl + CW_BAR + XB_ARR, (F.G % 8 != 0 || xb_xcc_id() != (unsigned)(blockIdx.x % 8)) ? 65537u : 1u);
    bf16* XN = (bf16*)(F.ws + WS_XN);
    const bool byb = (F.G == 256);
    for (int m0_ = gw; m0_ < M; m0_ += 2 * NGW) {
        const int wl_ = (F.vcu & 31) * NWAVES + F.wave, xq_ = F.vcu >> 5, p_ = m0_ / (2 * NGW);
        const int m = byb ? 2048 * xq_ + wl_ + 256 * ((2 * p_ + xq_) & 7) : m0_;
        const int m2 = byb ? 2048 * xq_ + wl_ + 256 * ((2 * p_ + 1 + xq_) & 7) : m + NGW;
        const GAS f32x4* xa = (const GAS f32x4*)(F.in[0] + (size_t)m * D) + F.lane; const GAS f32x4* xb = (const GAS f32x4*)(F.in[0] + (size_t)(m2 < M ? m2 : m) * D) + F.lane;
        const GAS f32x4* gr = (const GAS f32x4*)F.in[1] + F.lane;
        f32x4 va[4], vb[4]; float sa = 0.f, sb = 0.f;
#pragma unroll
        for (int j = 0; j < 4; ++j) { va[j] = xa[64 * j]; vb[j] = xb[64 * j]; }
#pragma unroll
        for (int j = 0; j < 4; ++j) { sa += (va[j].x * va[j].x + va[j].y * va[j].y) + (va[j].z * va[j].z + va[j].w * va[j].w); sb += (vb[j].x * vb[j].x + vb[j].y * vb[j].y) + (vb[j].z * vb[j].z + vb[j].w * vb[j].w); }
        const float ra = 1.f / sqrtf(wave_sum(sa) * (1.f / D) + EPS), rb = 1.f / sqrtf(wave_sum(sb) * (1.f / D) + EPS);
        GAS unsigned long long* oa = (GAS unsigned long long*)(XN + (size_t)m * D) + F.lane; GAS unsigned long long* ob = (GAS unsigned long long*)(XN + (size_t)(m2 < M ? m2 : m) * D) + F.lane;
#pragma unroll
        for (int j = 0; j < 4; ++j) { const f32x4 gg = gr[64 * j];
            oa[64 * j] = (unsigned long long)pk2(va[j].x * ra * gg.x, va[j].y * ra * gg.y) | ((unsigned long long)pk2(va[j].z * ra * gg.z, va[j].w * ra * gg.w) << 32);
            if (m2 < M) ob[64 * j] = (unsigned long long)pk2(vb[j].x * rb * gg.x, vb[j].y * rb * gg.y) | ((unsigned long long)pk2(vb[j].z * rb * gg.z, vb[j].w * rb * gg.w) << 32); }
    }
}

__device__ __forceinline__ void p0_ret_table(Frame& F) {
    const int gt = (F.vcu * NWAVES + F.wave) * 64 + F.lane, NGT = F.G * NWAVES * 64;
    float* cosr = (float*)(F.ws + WS_COSR); float* sinr = (float*)(F.ws + WS_SINR);
    for (int i = gt; i < SEQ * 128; i += NGT) { const int pos = i >> 7, d = i & 127; const double inv = exp2(-((double)d / 127.0) * 13.287712379549449); double s, c; sincos((double)pos * inv, &s, &c);
        const float cf = (float)c, sf = (float)s; asm volatile("global_store_dword %0, %1, off sc1\n\tglobal_store_dword %2, %3, off sc1" :: "v"(cosr + i), "v"(cf), "v"(sinr + i), "v"(sf) : "memory"); }
}
using pg8::Unit;
typedef const pg8::f32x4 (&AccRef)[2][2][4][2];
typedef pg8::f32x4 (&AccMut)[2][2][4][2];

#ifndef WT_STORES
#define WT_STORES 0
#endif
__device__ __forceinline__ void st16(void* p, v4u v) {
#if WT_STORES
    asm volatile("global_store_dwordx4 %0, %1, off sc1\n\ts_nop 1" :: "v"(p), "v"(v) : "memory");
#else
    *(v4u*)p = v;
#endif
}
__device__ __forceinline__ float sigmoidf_(float v) { return __builtin_amdgcn_rcpf(1.f + __builtin_amdgcn_exp2f(v * -1.4426950408889634f)); }
__device__ __forceinline__ float lg2gamma(int h) { return log2f(1.f - exp2f(-5.f - (float)h)); }

__device__ __forceinline__ size_t m1_off(int row) { return (size_t)(row >> 11) * (4u << 20) + (size_t)(row & 2047) * 1024; }
struct SchedPlain {
    pg8::TileOrder T; const char* A; const char* B; int lda, ldb, nt, pn0;
    __device__ bool next(int i, Unit& u) const {
        int pm, pn; if (!T.tile(i, pm, pn)) return false;
        u.A = A + (size_t)pm * 256 * lda * 2; u.B = B + (size_t)(pn0 + pn) * 256 * ldb * 2; u.rows = nullptr; u.nt = nt; u.pm = pm; u.pn = pn0 + pn; u.part = 0; u.aux = 0; u.fin = true; return true;
    }
};

struct SchedConstAB {
    SchedPlain S;
    __device__ bool next(int i, Unit& u) const { if (!S.next(i, u)) return false; u.A = S.A; u.B = S.B; return true; }
};
struct EpiNull {
    static constexpr bool PERM = true; static constexpr bool SIGNAL = false;
    __device__ __forceinline__ void operator()(AccRef acc, const Unit& u, int, int, int, int) const {
#pragma unroll
        for (int a = 0; a < 2; ++a)
#pragma unroll
            for (int b = 0; b < 2; ++b)
#pragma unroll
                for (int m = 0; m < 4; ++m)
#pragma unroll
                    for (int n = 0; n < 2; ++n) asm volatile("" :: "v"(acc[a][b][m][n]));
    }
};
struct EpiStoreOnly {
    static constexpr bool PERM = true; static constexpr bool SIGNAL = false;
    bf16* O;
    __device__ __forceinline__ void operator()(AccRef acc, const Unit& u, int wr, int wc, int fr, int fq) const {
        const int row0 = u.pm * 256 + wr * 64 + fr, cl = 32 * wc + 8 * fq;
#pragma unroll
        for (int bj = 0; bj < 2; ++bj)
#pragma unroll
            for (int ai = 0; ai < 2; ++ai)
#pragma unroll
                for (int m = 0; m < 4; ++m) { v4u w;
#pragma unroll
                    for (int n = 0; n < 2; ++n) { const pg8::f32x4 v = acc[ai][bj][m][n]; w[2 * n] = pg8::cvt_pk_bf16(v[0], v[1]); w[2 * n + 1] = pg8::cvt_pk_bf16(v[2], v[3]); }
                    *(v4u*)(O + (size_t)(row0 + ai * 128 + m * 16) * 1024 + ((u.pn & 3) * 256) + 128 * bj + cl) = w; }
    }
};
struct EpiProj {
    static constexpr bool PERM = true; static constexpr bool SIGNAL = false;
    unsigned char* ws; bf16* outb; const float* const* in;
    __device__ __forceinline__ void operator()(AccRef acc, const Unit& u, int wr, int wc, int fr, int fq) const {
        const int T = u.pn;
        const int row0 = u.pm * 256 + wr * 64 + fr;
        if (T < 8) {
            bf16* QA = (bf16*)(ws + WS_QA); bf16* KA = (bf16*)(ws + WS_KA); const float* cosa = (const float*)(ws + WS_COSA); const float* sina = (const float*)(ws + WS_SINA); const float* gq = in[4]; const float* gk = in[5];
            const bool isq = T < 4; const float* g = isq ? gq : gk; bf16* O = isq ? QA : KA;
            const int head = 4 * (T & 3) + wc;
            f32x4 glo[2], ghi[2];
#pragma unroll
            for (int n = 0; n < 2; ++n) { glo[n] = *(const f32x4*)(g + 8 * fq + 4 * n); ghi[n] = *(const f32x4*)(g + 32 + 8 * fq + 4 * n); }
            f32x4 tb[3][4];
#define EP_LOADA(G) do { const int pos_ = (row0 + ((G) >> 2) * 128 + ((G) & 3) * 16) & (SEQ - 1); \
                _Pragma("unroll") for (int n = 0; n < 2; ++n) { tb[(G) % 3][2 * n] = *(const f32x4*)(cosa + pos_ * 32 + 8 * fq + 4 * n); tb[(G) % 3][2 * n + 1] = *(const f32x4*)(sina + pos_ * 32 + 8 * fq + 4 * n); } } while (0)
            EP_LOADA(0); EP_LOADA(1);
#pragma unroll
            for (int g8 = 0; g8 < 8; ++g8) { const int ai = g8 >> 2, m = g8 & 3; {
                    if (g8 + 2 < 8) EP_LOADA(g8 + 2);
                    const int row = row0 + ai * 128 + m * 16;
                    float ss = 0.f;
#pragma unroll
                    for (int bj = 0; bj < 2; ++bj)
#pragma unroll
                        for (int n = 0; n < 2; ++n) { const pg8::f32x4 v = acc[ai][bj][m][n]; ss += (v[0] * v[0] + v[1] * v[1]) + (v[2] * v[2] + v[3] * v[3]); }
                    { auto r16 = __builtin_amdgcn_permlane16_swap(__float_as_uint(ss), __float_as_uint(ss), false, false); ss = __uint_as_float(r16[0]) + __uint_as_float(r16[1]);
                      auto r32 = __builtin_amdgcn_permlane32_swap(__float_as_uint(ss), __float_as_uint(ss), false, false); ss = __uint_as_float(r32[0]) + __uint_as_float(r32[1]); }
                    const float rinv = __builtin_amdgcn_rsqf(ss * (1.f / 64.f) + EPS) * (isq ? C2 : 1.f);
                    v4u wlo, whi;
#pragma unroll
                    for (int n = 0; n < 2; ++n) {
                        const f32x4 c = tb[g8 % 3][2 * n], s = tb[g8 % 3][2 * n + 1];
                        const f32x4 lo = acc[ai][0][m][n] * rinv * glo[n], hi = acc[ai][1][m][n] * rinv * ghi[n];
                        const f32x4 olo = lo * c - hi * s, ohi = hi * c + lo * s;
                        wlo[2 * n] = pg8::cvt_pk_bf16(olo[0], olo[1]); wlo[2 * n + 1] = pg8::cvt_pk_bf16(olo[2], olo[3]);
                        whi[2 * n] = pg8::cvt_pk_bf16(ohi[0], ohi[1]); whi[2 * n + 1] = pg8::cvt_pk_bf16(ohi[2], ohi[3]);
                    }
                    bf16* p = O + (size_t)row * 1024 + head * 64 + 8 * fq;
                    st16(p, wlo); st16(p + 32, whi);
                } }
#undef EP_LOADA
        } else if (T >= 12 && T < 20) {
            bf16* QR = (bf16*)(ws + WS_QR); bf16* KR = (bf16*)(ws + WS_KR); const float* cosr = (const float*)(ws + WS_COSR); const float* sinr = (const float*)(ws + WS_SINR);
            const bool isq = T < 16; bf16* O = isq ? QR : KR; const int head = T & 3;
            const float lg = lg2gamma(head);
            f32x4 tb[3][4];
#define EP_LOADR(G) do { const int pos_ = (row0 + ((G) >> 2) * 128 + ((G) & 3) * 16) & (SEQ - 1); \
                _Pragma("unroll") for (int n = 0; n < 2; ++n) { tb[(G) % 3][2 * n] = *(const f32x4*)(cosr + pos_ * 128 + 32 * wc + 8 * fq + 4 * n); tb[(G) % 3][2 * n + 1] = *(const f32x4*)(sinr + pos_ * 128 + 32 * wc + 8 * fq + 4 * n); } } while (0)
            EP_LOADR(0); EP_LOADR(1);
#pragma unroll
            for (int g8 = 0; g8 < 8; ++g8) { const int ai = g8 >> 2, m = g8 & 3; {
                    if (g8 + 2 < 8) EP_LOADR(g8 + 2);
                    const int row = row0 + ai * 128 + m * 16, pos = row & (SEQ - 1), ic = pos & (RCH - 1);
                    const float fac = isq ? exp2f((float)ic * lg) : exp2f(-(float)ic * lg) * 0.0625f;
                    v4u wlo, whi;
#pragma unroll
                    for (int n = 0; n < 2; ++n) {
                        const f32x4 c = tb[g8 % 3][2 * n], s = tb[g8 % 3][2 * n + 1];
                        const f32x4 lo = acc[ai][0][m][n] * fac, hi = acc[ai][1][m][n] * fac;
                        const f32x4 olo = lo * c - hi * s, ohi = hi * c + lo * s;
                        wlo[2 * n] = pg8::cvt_pk_bf16(olo[0], olo[1]); wlo[2 * n + 1] = pg8::cvt_pk_bf16(olo[2], olo[3]);
                        whi[2 * n] = pg8::cvt_pk_bf16(ohi[0], ohi[1]); whi[2 * n + 1] = pg8::cvt_pk_bf16(ohi[2], ohi[3]);
                    }
                    bf16* p = isq ? O + ((size_t)((row >> 5) * 4 + head) * 16 + 2 * wc + (fq >> 1)) * 512 + ((fq & 1) * 32 + (row & 31)) * 8 : O + (size_t)row * 1024 + head * 256 + 32 * wc + 8 * fq;
                    st16(p, wlo); st16(p + (isq ? 8 * 512 : 128), whi);
                } }
#undef EP_LOADR
        } else {
            bf16* VA = (bf16*)(ws + WS_VA); bf16* V01 = (bf16*)(ws + WS_V01); bf16* V23 = (bf16*)(ws + WS_V23); bf16* GR = outb; bf16* GA = (bf16*)(ws + WS_QR); bf16* GB = (bf16*)(ws + WS_KR);     const float* bgate = in[3];
            bf16* O; int ldo, col0, act = 0; const float* bias = nullptr;
            if (T < 12) { O = VA; ldo = 1024; col0 = 256 * (T - 8); }
            else if (T < 28) { const int hh = (T - 20) >> 1, sh = (T - 20) & 1; O = hh < 2 ? V01 : V23; ldo = 1024; col0 = (hh & 1) * 512 + 256 * sh; }
            else if (T < 36) { O = GR; ldo = 2048; col0 = 256 * (T - 28); act = 1; }
            else if (T < 40) { O = GA; ldo = 1024; col0 = 256 * (T - 36); act = 2; bias = bgate + col0; }
            else { O = GB; ldo = 1024; col0 = 256 * (T - 40); act = 2; bias = bgate + 1024 + col0; }
            const int cl = 32 * wc + 8 * fq;
#pragma unroll
            for (int bj = 0; bj < 2; ++bj) {
                f32x4 bv[2] = {(f32x4){0.f, 0.f, 0.f, 0.f}, (f32x4){0.f, 0.f, 0.f, 0.f}};
                if (bias) { bv[0] = *(const f32x4*)(bias + 128 * bj + cl); bv[1] = *(const f32x4*)(bias + 128 * bj + cl + 4); }
#pragma unroll
                for (int ai = 0; ai < 2; ++ai)
#pragma unroll
                    for (int m = 0; m < 4; ++m) {
                        const int row = row0 + ai * 128 + m * 16;
                        v4u w;
#pragma unroll
                        for (int n = 0; n < 2; ++n) {
                            f32x4 v = acc[ai][bj][m][n] + bv[n];
                            if (act == 1) { v[0] = v[0] * sigmoidf_(v[0]); v[1] = v[1] * sigmoidf_(v[1]); v[2] = v[2] * sigmoidf_(v[2]); v[3] = v[3] * sigmoidf_(v[3]); }
                            else if (act == 2) { v[0] = sigmoidf_(v[0]); v[1] = sigmoidf_(v[1]); v[2] = sigmoidf_(v[2]); v[3] = sigmoidf_(v[3]); }
                            w[2 * n] = pg8::cvt_pk_bf16(v[0], v[1]); w[2 * n + 1] = pg8::cvt_pk_bf16(v[2], v[3]);
                        }
                        st16(O + (size_t)row * ldo + col0 + 128 * bj + cl, w);
                    }
            }
        }
    }
};

struct SchedMix {
    pg8::TileOrder T; const char* ATT; const char* W;
    __device__ bool next(int i, Unit& u) const {
        const int ti = i / 3, part = i - ti * 3; int pm, pn; if (!T.tile(ti, pm, pn)) return false;
        const size_t rowoff = (size_t)pm * 256 * 1024 * 2;
        u.A = ATT + (part == 2 ? (size_t)0 : (part == 0 ? (size_t)(WS_V01 - WS_QA) : (size_t)(WS_V23 - WS_QA))) + rowoff; u.B = W + (size_t)pn * 256 * 3072 * 2 + (size_t)(part == 2 ? 0 : part + 1) * 1024 * 2; u.nt = 16;
        u.rows = nullptr; u.pm = pm; u.pn = pn; u.part = part; u.aux = 0; u.fin = (part != 0); return true;
    }
};
struct EpiMix {
    static constexpr bool PERM = true; static constexpr bool SIGNAL = false;
    const bf16 *GA, *GB; bf16* M1; bf16* MRG;
    __device__ __forceinline__ void operator()(AccRef acc, const Unit& u, int wr, int wc, int fr, int fq) const {
        const int row0 = u.pm * 256 + wr * 64 + fr, colb = u.pn * 256 + 32 * wc + 8 * fq;
        const bool p0 = (u.part == 1); const bf16* G = p0 ? GB : GA;
        v4u gb[3][2], mb[3][2];
#define EM_LOAD(GI) do { const int row_ = row0 + ((GI) >> 2) * 128 + ((GI) & 3) * 16; \
            _Pragma("unroll") for (int bj = 0; bj < 2; ++bj) { gb[(GI) % 3][bj] = *(const v4u*)(G + (size_t)row_ * 1024 + colb + 128 * bj); \
                if (!p0) mb[(GI) % 3][bj] = *(const v4u*)(M1 + m1_off(row_) + colb + 128 * bj); } } while (0)
        EM_LOAD(0); EM_LOAD(1);
#pragma unroll
        for (int gi = 0; gi < 8; ++gi) { const int ai = gi >> 2, m = gi & 3;
                if (gi + 2 < 8) EM_LOAD(gi + 2);
                const size_t ro = (size_t)(row0 + ai * 128 + m * 16) * 1024 + colb;
#pragma unroll
                for (int bj = 0; bj < 2; ++bj) {
                    const v4u g = gb[gi % 3][bj];
                    f32x4 v0 = acc[ai][bj][m][0], v1 = acc[ai][bj][m][1];
                    v0[0] *= bflo(g[0]); v0[1] *= bfhi(g[0]); v0[2] *= bflo(g[1]); v0[3] *= bfhi(g[1]);
                    v1[0] *= bflo(g[2]); v1[1] *= bfhi(g[2]); v1[2] *= bflo(g[3]); v1[3] *= bfhi(g[3]);
                    bf16* mp = M1 + m1_off(row0 + ai * 128 + m * 16) + colb + 128 * bj;
                    if (p0) { v4u w; w[0] = pg8::cvt_pk_bf16(v0[0], v0[1]); w[1] = pg8::cvt_pk_bf16(v0[2], v0[3]); w[2] = pg8::cvt_pk_bf16(v1[0], v1[1]); w[3] = pg8::cvt_pk_bf16(v1[2], v1[3]); *(v4u*)mp = w; }
                    else { const v4u pm = mb[gi % 3][bj];
                        v0[0] += bflo(pm[0]); v0[1] += bfhi(pm[0]); v0[2] += bflo(pm[1]); v0[3] += bfhi(pm[1]); v1[0] += bflo(pm[2]); v1[1] += bfhi(pm[2]); v1[2] += bflo(pm[3]); v1[3] += bfhi(pm[3]);
                        v4u w; w[0] = pg8::cvt_pk_bf16(v0[0], v0[1]); w[1] = pg8::cvt_pk_bf16(v0[2], v0[3]); w[2] = pg8::cvt_pk_bf16(v1[0], v1[1]); w[3] = pg8::cvt_pk_bf16(v1[2], v1[3]);
                        *(v4u*)(MRG + ro + 128 * bj) = w; }
                }
        }
#undef EM_LOAD
    }
};

struct EpiOut {
    static constexpr bool PERM = false; static constexpr bool SIGNAL = false;
    const float* X; float* O;
    __device__ __forceinline__ void operator()(AccRef acc, const Unit& u, int wr, int wc, int fr, int fq) const {
        const int row0 = u.pm * 256 + wr * 64 + fr, col0 = u.pn * 256 + wc * 32 + 4 * fq;
        const size_t off0 = (size_t)row0 * D + col0;
        f32x4 xb[3][4];
#define EO_LOAD(G) do { const size_t off_ = off0 + (size_t)(((G) >> 2) * 128 + ((G) & 3) * 16) * D; \
            _Pragma("unroll") for (int bj = 0; bj < 2; ++bj) _Pragma("unroll") for (int n = 0; n < 2; ++n) xb[(G) % 3][2 * bj + n] = *(const f32x4*)(X + off_ + bj * 128 + n * 16); } while (0)
        EO_LOAD(0); EO_LOAD(1);
#pragma unroll
        for (int g = 0; g < 8; ++g) { const int ai = g >> 2, m = g & 3; const size_t off = off0 + (size_t)(ai * 128 + m * 16) * D;
            if (g + 2 < 8) EO_LOAD(g + 2);
#pragma unroll
            for (int bj = 0; bj < 2; ++bj)
#pragma unroll
                for (int n = 0; n < 2; ++n) *(f32x4*)(O + off + bj * 128 + n * 16) = xb[g % 3][2 * bj + n] + acc[ai][bj][m][n]; }
#undef EO_LOAD
    }
};


__device__ __forceinline__ void attn_simple(Frame& F) {
    const bf16* QA = (const bf16*)(F.ws + WS_QA); const bf16* KA = (const bf16*)(F.ws + WS_KA); const bf16* VA = (const bf16*)(F.ws + WS_VA); bf16* O = (bf16*)(F.ws + WS_QA);
    const int gw = F.vcu * NWAVES + F.wave, NGW = F.G * NWAVES, d = F.lane;
    for (int task = gw; task < M * AH; task += NGW) {
        const int h = task & 15, tok = task >> 4, b = tok >> 11, t = tok & (SEQ - 1);
        const float q = bf2f(QA[(size_t)tok * 1024 + h * 64 + d]);
        float mx = -INFINITY, l = 0.f, o = 0.f;
#pragma unroll 1
        for (int p = 0; p < 3; ++p) {
            const int r = p == 0 ? 1 : (p == 1 ? 4 : 16);
#pragma unroll 2
            for (int j = 0; j <= 128; ++j) {
                const int s = t - r * j; if (s < 0) break;
                const size_t ko = (size_t)(b * SEQ + s) * 1024 + h * 64 + d;
                const float sc = wave_sum(q * bf2f(KA[ko]));
                const float mn = fmaxf(mx, sc), corr = exp2f(mx - mn), pj = exp2f(sc - mn);
                l = l * corr + pj; o = o * corr + pj * bf2f(VA[ko]); mx = mn;
            }
        }
        O[(size_t)tok * 1024 + h * 64 + d] = (bf16)f2bf(o / l);
    }
}

__device__ __forceinline__ void ret_simple_chunk(Frame& F, int n) {
    const bf16* QR = (const bf16*)(F.ws + WS_QR); const bf16* KR = (const bf16*)(F.ws + WS_KR);
    const bf16* GR = (const bf16*)F.out; bf16* TMP = (bf16*)(F.ws + WS_TMP); float* SS = (float*)(F.ws + WS_SS);
    const int gw = F.vcu * NWAVES + F.wave, NGW = F.G * NWAVES, lane = F.lane;
    for (int task = gw; task < NB * RH * RCH; task += NGW) {
        const int i = task & 127, h = (task >> 7) & 3, b = task >> 9, t = n * RCH + i, tok = b * SEQ + t;
        const bf16* V = (const bf16*)(F.ws + (h < 2 ? WS_V01 : WS_V23));
        const float lg = lg2gamma(h);
        const v2u qw = *(const v2u*)(QR + (size_t)tok * 1024 + h * 256 + 4 * lane);
        const float q0 = bflo(qw[0]), q1 = bfhi(qw[0]), q2 = bflo(qw[1]), q3 = bfhi(qw[1]);
        float y[8];
#pragma unroll
        for (int e = 0; e < 8; ++e) y[e] = 0.f;
        for (int s = 0; s <= t; ++s) {
            const size_t srow = (size_t)(b * SEQ + s);
            const v2u kw = *(const v2u*)(KR + srow * 1024 + h * 256 + 4 * lane);
            float dot = q0 * bflo(kw[0]) + q1 * bfhi(kw[0]) + q2 * bflo(kw[1]) + q3 * bfhi(kw[1]);
            dot = wave_sum(dot) * exp2f((float)(RCH * (n - (s >> 7))) * lg);
            const v4u vw = *(const v4u*)(V + srow * 1024 + (h & 1) * 512 + 8 * lane);
#pragma unroll
            for (int e = 0; e < 4; ++e) { y[2 * e] += dot * bflo(vw[e]); y[2 * e + 1] += dot * bfhi(vw[e]); }
        }
        float ss = 0.f;
#pragma unroll
        for (int e = 0; e < 8; ++e) ss += y[e] * y[e];
        ss = wave_sum(ss);
        if (lane == 0) SS[tok * 4 + h] = ss;
        const float rinv = 1.f / sqrtf(ss * (1.f / 512.f) + EPS);
        const float* g = F.in[7] + h * 512 + 8 * lane;
        const v4u gw4 = *(const v4u*)(GR + (size_t)tok * 2048 + h * 512 + 8 * lane);
        v4u w;
#pragma unroll
        for (int e = 0; e < 4; ++e) w[e] = pk2(y[2 * e] * rinv * g[2 * e] * bflo(gw4[e]), y[2 * e + 1] * rinv * g[2 * e + 1] * bfhi(gw4[e]));
        *(v4u*)(TMP + ((size_t)(b * RCH + i) * 2048 + h * 512 + 8 * lane)) = w;
    }
}
__device__ __forceinline__ void ret_simple_copy(Frame& F, int n) {
    const bf16* TMP = (const bf16*)(F.ws + WS_TMP);
    const int gt = (F.vcu * NWAVES + F.wave) * 64 + F.lane, NGT = F.G * NWAVES * 64;
    for (int idx = gt; idx < NB * RCH * 256; idx += NGT) {
        const int c8 = idx & 255, i = (idx >> 8) & 127, b = idx >> 15, col = c8 * 8, h = col >> 9;
        bf16* V = (bf16*)(F.ws + (h < 2 ? WS_V01 : WS_V23));
        *(v4u*)(V + (size_t)(b * SEQ + n * RCH + i) * 1024 + (h & 1) * 512 + (col & 511)) = *(const v4u*)(TMP + (size_t)(b * RCH + i) * 2048 + col);
    }
}
typedef float f32x16 __attribute__((ext_vector_type(16)));
typedef short s16x4 __attribute__((ext_vector_type(4)));
typedef short v4i16_t __attribute__((ext_vector_type(4)));
#define MFMA32(a, b, c) __builtin_amdgcn_mfma_f32_32x32x16_bf16((a), (b), (c), 0, 0, 0)
__device__ __forceinline__ int crow(int r, int hi) { return (r & 3) + 8 * (r >> 2) + 4 * hi; }
__device__ __forceinline__ s16x4 vtr(const LAS unsigned char* p) { return __builtin_bit_cast(s16x4, __builtin_amdgcn_ds_read_tr16_b64_v4i16((LAS v4i16_t*)p)); }
__device__ __forceinline__ float half_max(float m) { auto rr = __builtin_amdgcn_permlane32_swap(__float_as_uint(m), __float_as_uint(m), false, false); return fmaxf(__uint_as_float(rr[0]), __uint_as_float(rr[1])); }
__device__ __forceinline__ float half_sum(float m) { auto rr = __builtin_amdgcn_permlane32_swap(__float_as_uint(m), __float_as_uint(m), false, false); return __uint_as_float(rr[0]) + __uint_as_float(rr[1]); }
__device__ __forceinline__ bf16x8 pack8(const f32x16& p, int s) {
    v4u w; w[0] = pg8::cvt_pk_bf16(p[8 * s], p[8 * s + 1]); w[1] = pg8::cvt_pk_bf16(p[8 * s + 2], p[8 * s + 3]); w[2] = pg8::cvt_pk_bf16(p[8 * s + 4], p[8 * s + 5]); w[3] = pg8::cvt_pk_bf16(p[8 * s + 6], p[8 * s + 7]);
    return __builtin_bit_cast(bf16x8, w);
}
constexpr int AT_OACC = 0;
constexpr int AT_MS = 65536, AT_LS = 67584;
constexpr int AT_WSF = 69632;
constexpr int AT_VB = 73728;
constexpr int AT_KB = AT_VB + 8 * 4096;
static_assert(AT_KB + 8 * 4096 <= LDSCTL_OFF, "attention LDS map");

#ifndef AABL
#define AABL 0
#endif
struct AttnTask { int b, h, U0, r, c, g, st, kt0; bool valid; };
__device__ __forceinline__ AttnTask attn_desc(const Frame& F, int i) {
    AttnTask T; const int ui = i / 6, rem = i - ui * 6; T.st = rem >> 1; const int tt = rem & 1;
    const int idx = F.vcu + ui * F.G; T.valid = idx < 512;
    const int rnd = idx >> 8, v8 = idx & 255, bh = 64 * rnd + (v8 >> 2), G = rnd == 0 ? (v8 & 3) : 3 - (v8 & 3);
    T.b = bh >> 4; T.h = bh & 15; T.U0 = 512 * G;
    T.r = T.st == 0 ? 1 : (T.st == 1 ? 4 : 16); const int npc = 16 / T.r, tau = F.wave * 2 + tt;
    T.c = tau / npc; T.g = tau % npc;
    const int iq0 = T.U0 / T.r + 32 * T.g; const int kt = 4 - (iq0 >> 5); T.kt0 = kt < 0 ? 0 : kt;
    return T;
}
__device__ __forceinline__ void attention_phase(Frame& F, bf16* O, const int abl) {
    const bf16* QA = (const bf16*)(F.ws + WS_QA); const bf16* KA = (const bf16*)(F.ws + WS_KA); const bf16* VA = (const bf16*)(F.ws + WS_VA);
    const int lane = F.lane, r32 = lane & 31, hi = lane >> 5, wave = F.wave;
    LAS unsigned char* lds = F.lds + RING_OFF;
    LAS float* wsf = (LAS float*)(lds + AT_WSF) + wave * 128;
    LAS unsigned char* vb = lds + AT_VB + wave * 4096;
    LAS unsigned char* kb = lds + AT_KB + wave * 4096;
    const LAS unsigned char* krd = kb + r32 * 128;
    const int kxr = 16 * (hi ^ ((r32 >> 1) & 7));
    const LAS unsigned char* vrd = vb + ((lane >> 4) & 1) * 32 + (lane & 3) * 8 + (4 * hi + ((lane & 15) >> 2)) * 64;
    const int vkk = lane >> 3, vch = lane & 7;
    bf16x8 qn[4]; v4u kn[4], vn[4];
#define AT_PREFETCH(TT, KT) do { const size_t rowb_ = (size_t)(TT).b * SEQ; const int ik0_ = (TT).U0 / (TT).r + 32 * (TT).g - 128 + 32 * (KT); \
        _Pragma("unroll") for (int i_ = 0; i_ < 4; ++i_) kn[i_] = *(const v4u*)(KA + (rowb_ + (TT).c + (TT).r * (ik0_ + vkk + 8 * i_)) * 1024 + (TT).h * 64 + 8 * vch); \
        _Pragma("unroll") for (int i_ = 0; i_ < 4; ++i_) vn[i_] = *(const v4u*)(VA + (rowb_ + (TT).c + (TT).r * (ik0_ + vkk + 8 * i_)) * 1024 + (TT).h * 64 + 8 * vch); } while (0)
#define AT_FIRST(TT) do { const bf16* qp_ = QA + ((size_t)(TT).b * SEQ + (TT).c + (TT).r * ((TT).U0 / (TT).r + 32 * (TT).g + r32)) * 1024 + (TT).h * 64 + 8 * hi; \
        _Pragma("unroll") for (int s = 0; s < 4; ++s) qn[s] = *(const bf16x8*)(qp_ + 16 * s); \
        AT_PREFETCH(TT, (TT).kt0); } while (0)
    AttnTask T = attn_desc(F, 0);
    if (T.valid) AT_FIRST(T);
#pragma unroll 1
    for (int ti = 0; T.valid; ++ti) {
        const AttnTask N = attn_desc(F, ti + 1);
        bf16x8 qf[4];
#pragma unroll
        for (int s = 0; s < 4; ++s) qf[s] = qn[s];
        float m = -1e30f, l = 0.f;
        f32x16 o0, o1;
#pragma unroll
        for (int i = 0; i < 16; ++i) { o0[i] = 0.f; o1[i] = 0.f; }
#pragma unroll 1
        for (int kt = T.kt0; kt <= 4; ++kt) {
#pragma unroll
            for (int i = 0; i < 4; ++i) *(LAS v4u*)(kb + (vkk + 8 * i) * 128 + 16 * (vch ^ (((vkk >> 1) + 4 * i) & 7))) = kn[i];
#pragma unroll
            for (int i = 0; i < 4; ++i) *(LAS v4u*)(vb + (vch >> 2) * 2048 + (vkk + 8 * i) * 64 + (vch & 3) * 16) = vn[i];
            bf16x8 kf[4];
#pragma unroll
            for (int s = 0; s < 4; ++s) kf[s] = *(const LAS bf16x8*)(krd + ((32 * s) ^ kxr));
            if (kt < 4) { if (!(abl & 1)) AT_PREFETCH(T, kt + 1); } else if (N.valid) AT_FIRST(N);
            if (abl & 8) { asm volatile("" :: "v"(kf[0]), "v"(kf[1]), "v"(kf[2]), "v"(kf[3])); continue; }
            f32x16 p;
#pragma unroll
            for (int i = 0; i < 16; ++i) p[i] = 0.f;
#pragma unroll
            for (int s = 0; s < 4; ++s) p = MFMA32(kf[s], qf[s], p);
            if (kt == 0) {
#pragma unroll
                for (int i = 0; i < 16; ++i) if (crow(i, hi) < r32) p[i] = -INFINITY;
            }
            if (kt == 4) {
#pragma unroll
                for (int i = 0; i < 16; ++i) if (crow(i, hi) > r32) p[i] = -INFINITY;
            }
            float tm = p[0];
#pragma unroll
            for (int i = 1; i < 16; ++i) tm = fmaxf(tm, p[i]);
            tm = half_max(tm);
            const float mn = fmaxf(m, tm), corr = __builtin_amdgcn_exp2f(m - mn);
            m = mn;
            float ps = 0.f;
#pragma unroll
            for (int i = 0; i < 16; ++i) { p[i] = __builtin_amdgcn_exp2f(p[i] - mn); ps += p[i]; }
            l = l * corr + ps;
            if (hi == 0) wsf[r32] = corr;
            const bf16x8 pa0 = pack8(p, 0), pa1 = pack8(p, 1);
#pragma unroll
            for (int i = 0; i < 16; ++i) { const float f = wsf[crow(i, hi)]; o0[i] *= f; o1[i] *= f; }
#pragma unroll
            for (int s = 0; s < 2; ++s) {
                const s16x4 a0 = vtr(vrd + s * 1024), a1 = vtr(vrd + s * 1024 + 512), b0 = vtr(vrd + 2048 + s * 1024), b1 = vtr(vrd + 2048 + s * 1024 + 512);
                const bf16x8 v0 = (bf16x8){a0[0], a0[1], a0[2], a0[3], a1[0], a1[1], a1[2], a1[3]}, v1 = (bf16x8){b0[0], b0[1], b0[2], b0[3], b1[0], b1[1], b1[2], b1[3]};
                o0 = MFMA32(s == 0 ? pa0 : pa1, v0, o0); o1 = MFMA32(s == 0 ? pa0 : pa1, v1, o1);
            }
        }
        if (!(abl & 4)) {
            l = half_sum(l);
            LAS float* MS = (LAS float*)(lds + AT_MS); LAS float* LS = (LAS float*)(lds + AT_LS);
            const int offq = T.c + T.r * (32 * T.g + r32);
            float fa = 0.f, fb = 1.f / l;
            if (T.st != 0) {
                const float mo = MS[offq], lo = LS[offq];
                const float mm = fmaxf(mo, m), wa = lo * __builtin_amdgcn_exp2f(mo - mm), wb = l * __builtin_amdgcn_exp2f(m - mm), ln = wa + wb;
                fa = wa / ln; fb = (wb / ln) / l; m = mm; l = ln;
            }
            if (hi == 0) { MS[offq] = m; LS[offq] = l; wsf[r32] = fa; wsf[32 + r32] = fb; }
            LAS unsigned short* OA = (LAS unsigned short*)(lds + AT_OACC);
            if (T.st == 0) {
#pragma unroll
                for (int i = 0; i < 16; ++i) { const int qq = crow(i, hi), off = T.c + T.r * (32 * T.g + qq); const float gb = wsf[32 + qq];
                    OA[off * 64 + r32] = (unsigned short)f2bf(gb * o0[i]); OA[off * 64 + 32 + r32] = (unsigned short)f2bf(gb * o1[i]); }
            } else {
#pragma unroll
                for (int i = 0; i < 16; ++i) { const int qq = crow(i, hi), off = T.c + T.r * (32 * T.g + qq); const float ga = wsf[qq], gb = wsf[32 + qq];
                    OA[off * 64 + r32] = (unsigned short)f2bf(gb * o0[i] + ga * bf2f(OA[off * 64 + r32])); OA[off * 64 + 32 + r32] = (unsigned short)f2bf(gb * o1[i] + ga * bf2f(OA[off * 64 + 32 + r32])); }
            }
        }
        if (ti & 1) {
            __syncthreads();
            if (T.st == 2) {
#pragma unroll
                for (int it = 0; it < 8; ++it) { const int pi = it * 512 + F.tid, row = pi >> 3, ch = pi & 7;
                    *(v4u*)(O + ((size_t)T.b * SEQ + T.U0 + row) * 1024 + T.h * 64 + ch * 8) = *(const LAS v4u*)(lds + AT_OACC + row * 128 + ch * 16); }
                __syncthreads();
            }
        }
        T = N;
    }
#undef AT_PREFETCH
#undef AT_FIRST
}

constexpr int RT_KI = 0;
constexpr int RT_VI = 65536;
constexpr int RT_PI = 81920;
constexpr int RT_PFJ = 150016;
constexpr int RT_ST = 114688;
constexpr int RT_RS = 147456;
static_assert(RT_RS + 512 <= LDSCTL_OFF, "retention LDS map");
__device__ __forceinline__ int swz16(int row) { return ((row & 3) << 2) | ((row >> 2) & 3); }
__device__ __forceinline__ int koff(int j, int ch) { return 512 * j + 16 * (ch ^ swz16(j)); }
__device__ __forceinline__ int pioff(int i, int ch) { return 256 * i + 16 * (ch ^ swz16(i)); }
__device__ __forceinline__ int voff(int j, int ch) { return 128 * j + 16 * (ch ^ (((j >> 1) & 1) << 2)); }

#define LAUNDER(x) asm volatile("" : "+v"(x))
#define LAUNDER(x) asm volatile("" : "+v"(x))
#ifndef RABL
#define RABL 0
#endif
#ifndef RPF
#define RPF 0
#endif
#ifndef RPF_DIST
#define RPF_DIST 3
#endif
__device__ __forceinline__ void retention_phase(Frame& F, const bool dummy) {
    const int abl = dummy ? RABL : 0;
    const int tid = F.tid, lane = F.lane, r32 = lane & 31, hi = lane >> 5, w = F.wave;
    const int tq = (lane & 15) >> 2, tp = lane & 3, tblk = (lane >> 4) & 1;
    LAS unsigned char* lds = F.lds + RING_OFF;
    const bf16* QR = (const bf16*)(F.ws + WS_QR); const bf16* KR = (const bf16*)(F.ws + WS_KR);
    const int ib = w >> 1, cb = w & 1;
    const int sw = swz16(r32);
    for (int idx = F.vcu; idx < 256; idx += F.G) {
        const int bh = idx >> 3, dvs = idx & 7, b = bh >> 2, h = bh & 3;
        bf16* Vb = (bf16*)(F.ws + (h < 2 ? WS_V01 : WS_V23)) + (h & 1) * 512 + 64 * dvs;
        const float lg = lg2gamma(h), gam = exp2f(lg), gC = exp2f(128.f * lg), gC1 = exp2f(127.f * lg);
        f32x16 st0, st1;
#pragma unroll
        for (int i = 0; i < 16; ++i) { st0[i] = 0.f; st1[i] = 0.f; }
        v4u kx[8], vx[2]; bf16x8 qf[16];
#define RT_LOAD_KV(N) do { const size_t r0_ = (size_t)b * SEQ + 128 * (N); int tidl_ = tid; LAUNDER(tidl_); \
            _Pragma("unroll") for (int it = 0; it < 8; ++it) { const int q = it * 512 + tidl_, j = q >> 5, ch = q & 31; kx[it] = *(const v4u*)(KR + (r0_ + j) * 1024 + h * 256 + 8 * ch); } \
            _Pragma("unroll") for (int it = 0; it < 2; ++it) { const int q = it * 512 + tidl_, j = q >> 3, ch = q & 7; vx[it] = *(const v4u*)(Vb + (r0_ + j) * 1024 + 8 * ch); } } while (0)
#define RT_STORE_KV() do { \
            _Pragma("unroll") for (int it = 0; it < 8; ++it) { const int q = it * 512 + tid, j = q >> 5, ch = q & 31; *(LAS v4u*)(lds + RT_KI + koff(j, ch)) = kx[it]; } \
            _Pragma("unroll") for (int it = 0; it < 2; ++it) { const int q = it * 512 + tid, j = q >> 3, ch = q & 7; *(LAS v4u*)(lds + RT_VI + voff(j, ch)) = vx[it]; } } while (0)
#define RT_BAR() asm volatile("s_waitcnt lgkmcnt(0)\n\ts_barrier" ::: "memory")
#define RT_LOAD_Q(N) do { int lnl_ = lane; LAUNDER(lnl_); const bf16* qp_ = QR + ((size_t)((b * SEQ + 128 * (N)) / 32 + ib) * 4 + h) * 8192 + 8 * lnl_;     \
            _Pragma("unroll") for (int s = 0; s < 16; ++s) qf[s] = *(const bf16x8*)(qp_ + 512 * s); } while (0)
#define RT_PREFETCH(N) do { if (RPF && (N) < 16 && tid < 256) { const size_t r0_ = (size_t)b * SEQ + 128 * (N); const bf16* p_; const int l_ = dvs * 64 + (tid & 63); \
            if (tid < 64) p_ = KR + (r0_ + (l_ >> 2)) * 1024 + h * 256 + 64 * (l_ & 3); else if (tid < 128) p_ = QR + ((size_t)(r0_ / 32 + (l_ >> 7)) * 4 + h) * 8192 + 64 * (l_ & 127); else p_ = Vb + (r0_ + (tid - 128)) * 1024; \
            unsigned sv_; asm volatile("s_mov_b32 %0, m0\n\ts_mov_b32 m0, %2\n\ts_nop 0\n\tglobal_load_lds_dword %1, off\n\ts_mov_b32 m0, %0" : "=&s"(sv_) : "v"(p_), "s"(pfbase)); } } while (0)
        const unsigned pfbase = __builtin_amdgcn_readfirstlane((unsigned)(size_t)F.lds + RT_PFJ + 256 * (w & 3));
        __syncthreads();
        RT_LOAD_KV(0); RT_LOAD_Q(0);
        RT_PREFETCH(1); RT_PREFETCH(2);
        for (int q = tid; q < 32768 / 16; q += 512) *(LAS v4u*)(lds + RT_ST + q * 16) = (v4u){0u, 0u, 0u, 0u};
        RT_STORE_KV();
        __syncthreads();
#pragma unroll 1
        for (int n = 0; n < 16; ++n) {
            const size_t row0 = (size_t)b * SEQ + 128 * n;
            int LX = 16 * (hi ^ sw), SWB = 16 * sw;
            LAUNDER(LX); LAUNDER(SWB);
            int r32l = r32, hil = hi; LAUNDER(r32l); LAUNDER(hil);
#pragma unroll 1
            for (int jj = 0; jj < 2; ++jj) {
                const int jb = 2 * jj + cb;
                if (jb <= ib && !(abl & 2)) {
                    f32x16 p;
#pragma unroll
                    for (int i = 0; i < 16; ++i) p[i] = 0.f;
                    const LAS unsigned char* kr = lds + RT_KI + 512 * (32 * jb + r32);
#pragma unroll
                    for (int s = 0; s < 16; ++s) { const bf16x8 kf = *(const LAS bf16x8*)(kr + ((32 * s) ^ LX)); p = MFMA32(kf, qf[s], p); }
                    if (jb == ib) {
#pragma unroll
                        for (int i = 0; i < 16; ++i) if (crow(i, hi) > r32) p[i] = 0.f;
                    }
                    LAS unsigned char* pw = lds + RT_PI + 256 * (32 * ib + r32) + 8 * hi;
#pragma unroll
                    for (int g = 0; g < 4; ++g) { v2u wv; wv[0] = pg8::cvt_pk_bf16(p[4 * g], p[4 * g + 1]); wv[1] = pg8::cvt_pk_bf16(p[4 * g + 2], p[4 * g + 3]);
                        *(LAS v2u*)(pw + ((64 * jb + 16 * g) ^ SWB)) = wv; }
                }
            }
            if (n < 15 && !(abl & 16)) RT_LOAD_KV(n + 1);
            RT_BAR();
            f32x16 ya, yc;
#pragma unroll
            for (int i = 0; i < 16; ++i) { ya[i] = 0.f; yc[i] = 0.f; }
            {
                const LAS unsigned char* pr = lds + RT_PI + 256 * (32 * ib + r32);
                const LAS unsigned char* vr = lds + RT_VI + voff(8 * hi + tq, 4 * cb + 2 * tblk + (tp >> 1)) + 8 * (tp & 1);
#pragma unroll
                for (int s = 0; s < 8; ++s) {
                    if (s < 2 * (ib + 1) && !(abl & 4)) {
                        const bf16x8 pa = *(const LAS bf16x8*)(pr + ((32 * s) ^ LX));
                        const s16x4 v0 = vtr(vr + 2048 * s), v1 = vtr(vr + 2048 * s + 512);
                        ya = MFMA32(((bf16x8){v0[0], v0[1], v0[2], v0[3], v1[0], v1[1], v1[2], v1[3]}), pa, ya);
                    }
                }
            }
            if (!(abl & 4)) { const LAS unsigned char* sr = lds + RT_ST + 512 * (32 * cb + r32);
#pragma unroll
              for (int s = 0; s < 16; ++s) { const bf16x8 sf = *(const LAS bf16x8*)(sr + ((32 * s) ^ LX)); yc = MFMA32(sf, qf[s], yc); } }
            if (n < 15 && !(abl & 16)) RT_LOAD_Q(n + 1);
            unsigned ypk[8];
#pragma unroll
            for (int i = 0; i < 8; ++i) ypk[i] = pk2(ya[2 * i] + gam * yc[2 * i], ya[2 * i + 1] + gam * yc[2 * i + 1]);
            if (!(abl & 8)) { f32x16 u0, u1;
#pragma unroll
              for (int i = 0; i < 16; ++i) { u0[i] = 0.f; u1[i] = 0.f; }
              const int kch = 4 * w + 2 * tblk + (tp >> 1);
              const LAS unsigned char* ka0 = lds + RT_KI + koff(8 * hi + tq, kch) + 8 * (tp & 1);
              const LAS unsigned char* ka1 = lds + RT_KI + koff(8 * hi + tq + 4, kch) + 8 * (tp & 1);
              const LAS unsigned char* va = lds + RT_VI + voff(8 * hi + tq, 2 * tblk + (tp >> 1)) + 8 * (tp & 1);
              const LAS unsigned char* vb2 = lds + RT_VI + voff(8 * hi + tq, 4 + 2 * tblk + (tp >> 1)) + 8 * (tp & 1);
#pragma unroll
              for (int s = 0; s < 8; ++s) {
                  const s16x4 k0 = vtr(ka0 + 8192 * s), k1 = vtr(ka1 + 8192 * s);
                  const bf16x8 ka = (bf16x8){k0[0], k0[1], k0[2], k0[3], k1[0], k1[1], k1[2], k1[3]};
                  const s16x4 a0 = vtr(va + 2048 * s), a1 = vtr(va + 2048 * s + 512), b0 = vtr(vb2 + 2048 * s), b1 = vtr(vb2 + 2048 * s + 512);
                  u0 = MFMA32(ka, ((bf16x8){a0[0], a0[1], a0[2], a0[3], a1[0], a1[1], a1[2], a1[3]}), u0);
                  u1 = MFMA32(ka, ((bf16x8){b0[0], b0[1], b0[2], b0[3], b1[0], b1[1], b1[2], b1[3]}), u1);
              }
#pragma unroll
              for (int i = 0; i < 16; ++i) { st0[i] = gC * st0[i] + gC1 * u0[i]; st1[i] = gC * st1[i] + gC1 * u1[i]; } }
            {
              const size_t tok = row0 + 32 * ib + r32l;
              bf16* yp = dummy ? (bf16*)(F.ws + WS_TMP) + (tok & 1023) * 1024 + 64 * dvs + 32 * cb + 4 * hil : Vb + tok * 1024 + 32 * cb + 4 * hil;
#pragma unroll
              for (int g = 0; g < 4; ++g) { v2u wv; wv[0] = ypk[2 * g]; wv[1] = ypk[2 * g + 1]; *(v2u*)(yp + 8 * g) = wv; } }
            RT_BAR();
            if (!(abl & 32)) { LAS unsigned char* sw0 = lds + RT_ST + 512 * r32 + 8 * hi; LAS unsigned char* sw1 = sw0 + 512 * 32;
#pragma unroll
              for (int g = 0; g < 4; ++g) {
                v2u w0, w1; w0[0] = pg8::cvt_pk_bf16(st0[4 * g], st0[4 * g + 1]); w0[1] = pg8::cvt_pk_bf16(st0[4 * g + 2], st0[4 * g + 3]);
                w1[0] = pg8::cvt_pk_bf16(st1[4 * g], st1[4 * g + 1]); w1[1] = pg8::cvt_pk_bf16(st1[4 * g + 2], st1[4 * g + 3]);
                const int o = (64 * w + 16 * g) ^ SWB;
                *(LAS v2u*)(sw0 + o) = w0; *(LAS v2u*)(sw1 + o) = w1;
              } }
            if (n < 15 && !(abl & 32)) RT_STORE_KV();
            RT_PREFETCH(n + RPF_DIST);
            RT_BAR();
        }
#undef RT_LOAD_KV
#undef RT_PREFETCH
#undef RT_STORE_KV
#undef RT_LOAD_Q
#undef RT_BAR
    }
}
__device__ __forceinline__ void retnorm_pass(Frame& F, const bool dummy = false) {
    const bf16* GR = (const bf16*)F.out;
    const int gw = F.vcu * NWAVES + F.wave, NGW = F.G * NWAVES, lane = F.lane;
    const bool byb = (F.G == 256);
    for (int m0 = gw; m0 < 4 * M; m0 += 2 * NGW) {
        bf16* Yp[2]; v4u yv[2], gv[2]; f32x4 g0[2], g1[2]; bool ok[2];
#pragma unroll
        for (int u = 0; u < 2; ++u) { int m = m0 + u * NGW; ok[u] = m < 4 * M; if (!ok[u]) m = m0;
            if (byb) m = 8192 * (F.vcu >> 5) + ((F.vcu & 31) * NWAVES + F.wave) + 256 * ((31 - (2 * (m0 / (2 * NGW)) + u) + 4 * (F.vcu >> 5)) & 31);
            const int tok = m >> 2, h = m & 3;
            Yp[u] = (bf16*)(F.ws + (h < 2 ? WS_V01 : WS_V23)) + (size_t)tok * 1024 + (h & 1) * 512 + 8 * lane;
            yv[u] = *(const v4u*)Yp[u]; gv[u] = *(const v4u*)(GR + (size_t)tok * 2048 + h * 512 + 8 * lane);
            g0[u] = *(const f32x4*)(F.in[7] + h * 512 + 8 * lane); g1[u] = *(const f32x4*)(F.in[7] + h * 512 + 8 * lane + 4); }
#pragma unroll
        for (int u = 0; u < 2; ++u) {
            float y[8];
#pragma unroll
            for (int e = 0; e < 4; ++e) { y[2 * e] = bflo(yv[u][e]); y[2 * e + 1] = bfhi(yv[u][e]); }
            float ss = 0.f;
#pragma unroll
            for (int e = 0; e < 8; ++e) ss += y[e] * y[e];
            const float r = 1.f / sqrtf(wave_sum(ss) * (1.f / 512.f) + EPS);
            v4u o;
            o[0] = pk2(y[0] * r * g0[u][0] * bflo(gv[u][0]), y[1] * r * g0[u][1] * bfhi(gv[u][0])); o[1] = pk2(y[2] * r * g0[u][2] * bflo(gv[u][1]), y[3] * r * g0[u][3] * bfhi(gv[u][1]));
            o[2] = pk2(y[4] * r * g1[u][0] * bflo(gv[u][2]), y[5] * r * g1[u][1] * bfhi(gv[u][2])); o[3] = pk2(y[6] * r * g1[u][2] * bflo(gv[u][3]), y[7] * r * g1[u][3] * bfhi(gv[u][3]));
            if (ok[u]) { if (dummy) *(v4u*)((bf16*)(F.ws + WS_TMP) + (((size_t)(Yp[u] - (bf16*)F.ws)) & (size_t)0x3fffff)) = o; else *(v4u*)Yp[u] = o; }
        }
    }
}
struct AttnCur { int ti, kt; };
__device__ __forceinline__ void attn_advance(const Frame& F, AttnCur& c) {
    if (c.kt < 4) { c.kt += 1; } else { c.ti += 1; c.kt = attn_desc(F, c.ti).kt0; }
}
__device__ __forceinline__ void attention_phase2(Frame& F, bf16* O) {
    const bf16* QA = (const bf16*)(F.ws + WS_QA); const bf16* KA = (const bf16*)(F.ws + WS_KA); const bf16* VA = (const bf16*)(F.ws + WS_VA);
    const int lane = F.lane, r32 = lane & 31, hi = lane >> 5, wave = F.wave;
    LAS unsigned char* lds = F.lds + RING_OFF;
    LAS float* wsf = (LAS float*)(lds + AT_WSF) + wave * 128;
    LAS unsigned char* vb = lds + AT_VB + wave * 4096;
    LAS unsigned char* kb = lds + AT_KB + wave * 4096;
    const LAS unsigned char* krd = kb + r32 * 128;
    const int kxr = 16 * (hi ^ ((r32 >> 1) & 7));
    const LAS unsigned char* vrd = vb + ((lane >> 4) & 1) * 32 + (lane & 3) * 8 + (4 * hi + ((lane & 15) >> 2)) * 64;
    const int vkk = lane >> 3, vch = lane & 7;
    bf16x8 qa[4], qb[4];
    v4u k0[4], v0[4], k1[4], v1[4];
    bf16x8 qf[4]; float m = -1e30f, l = 0.f; f32x16 o0, o1;
#pragma unroll
    for (int i = 0; i < 16; ++i) { o0[i] = 0.f; o1[i] = 0.f; }
#define A2_ISSUE(C, KN, VN) do { const AttnTask X_ = attn_desc(F, (C).ti); if (X_.valid) { const size_t rowb_ = (size_t)X_.b * SEQ; const int iq0_ = X_.U0 / X_.r + 32 * X_.g, ik0_ = iq0_ - 128 + 32 * (C).kt; \
        _Pragma("unroll") for (int i_ = 0; i_ < 4; ++i_) KN[i_] = *(const v4u*)(KA + (rowb_ + X_.c + X_.r * (ik0_ + vkk + 8 * i_)) * 1024 + X_.h * 64 + 8 * vch); \
        _Pragma("unroll") for (int i_ = 0; i_ < 4; ++i_) VN[i_] = *(const v4u*)(VA + (rowb_ + X_.c + X_.r * (ik0_ + vkk + 8 * i_)) * 1024 + X_.h * 64 + 8 * vch); \
        if ((C).kt == X_.kt0) { const bf16* qp_ = QA + (rowb_ + X_.c + X_.r * (iq0_ + r32)) * 1024 + X_.h * 64 + 8 * hi; \
            if ((C).ti & 1) { _Pragma("unroll") for (int s = 0; s < 4; ++s) qb[s] = *(const bf16x8*)(qp_ + 16 * s); } \
            else { _Pragma("unroll") for (int s = 0; s < 4; ++s) qa[s] = *(const bf16x8*)(qp_ + 16 * s); } } } } while (0)
#define A2_STEP(KN, VN) do { \
        const AttnTask T = attn_desc(F, c0.ti); const int kt = c0.kt; \
        if (kt == T.kt0) { m = -1e30f; l = 0.f; \
            _Pragma("unroll") for (int i = 0; i < 16; ++i) { o0[i] = 0.f; o1[i] = 0.f; } \
            if (c0.ti & 1) { _Pragma("unroll") for (int s = 0; s < 4; ++s) qf[s] = qb[s]; } else { _Pragma("unroll") for (int s = 0; s < 4; ++s) qf[s] = qa[s]; } } \
        _Pragma("unroll") for (int i = 0; i < 4; ++i) *(LAS v4u*)(kb + (vkk + 8 * i) * 128 + 16 * (vch ^ (((vkk >> 1) + 4 * i) & 7))) = KN[i]; \
        _Pragma("unroll") for (int i = 0; i < 4; ++i) *(LAS v4u*)(vb + (vch >> 2) * 2048 + (vkk + 8 * i) * 64 + (vch & 3) * 16) = VN[i]; \
        A2_ISSUE(c2, KN, VN); \
        bf16x8 kf[4]; \
        _Pragma("unroll") for (int s = 0; s < 4; ++s) kf[s] = *(const LAS bf16x8*)(krd + ((32 * s) ^ kxr)); \
        f32x16 p; \
        _Pragma("unroll") for (int i = 0; i < 16; ++i) p[i] = 0.f; \
        _Pragma("unroll") for (int s = 0; s < 4; ++s) p = MFMA32(kf[s], qf[s], p); \
        if (kt == 0) { _Pragma("unroll") for (int i = 0; i < 16; ++i) if (crow(i, hi) < r32) p[i] = -INFINITY; } \
        if (kt == 4) { _Pragma("unroll") for (int i = 0; i < 16; ++i) if (crow(i, hi) > r32) p[i] = -INFINITY; } \
        float tm = p[0]; \
        _Pragma("unroll") for (int i = 1; i < 16; ++i) tm = fmaxf(tm, p[i]); \
        tm = half_max(tm); \
        const float mn = fmaxf(m, tm), corr = __builtin_amdgcn_exp2f(m - mn); \
        m = mn; float ps = 0.f; \
        _Pragma("unroll") for (int i = 0; i < 16; ++i) { p[i] = __builtin_amdgcn_exp2f(p[i] - mn); ps += p[i]; } \
        l = l * corr + ps; \
        if (hi == 0) wsf[r32] = corr; \
        const bf16x8 pa0 = pack8(p, 0), pa1 = pack8(p, 1); \
        _Pragma("unroll") for (int i = 0; i < 16; ++i) { const float f = wsf[crow(i, hi)]; o0[i] *= f; o1[i] *= f; } \
        _Pragma("unroll") for (int s = 0; s < 2; ++s) { \
            const s16x4 a0 = vtr(vrd + s * 1024), a1 = vtr(vrd + s * 1024 + 512), b0 = vtr(vrd + 2048 + s * 1024), b1 = vtr(vrd + 2048 + s * 1024 + 512); \
            const bf16x8 vv0 = (bf16x8){a0[0], a0[1], a0[2], a0[3], a1[0], a1[1], a1[2], a1[3]}, vv1 = (bf16x8){b0[0], b0[1], b0[2], b0[3], b1[0], b1[1], b1[2], b1[3]}; \
            o0 = MFMA32(s == 0 ? pa0 : pa1, vv0, o0); o1 = MFMA32(s == 0 ? pa0 : pa1, vv1, o1); } \
        if (kt == 4) {   \
            float lt = half_sum(l), mt = m; \
            LAS float* MS = (LAS float*)(lds + AT_MS); LAS float* LS = (LAS float*)(lds + AT_LS); \
            const int offq = T.c + T.r * (32 * T.g + r32); \
            float fa = 0.f, fb = 1.f / lt; \
            if (T.st != 0) { const float mo = MS[offq], lo = LS[offq]; \
                const float mm = fmaxf(mo, mt), wa = lo * __builtin_amdgcn_exp2f(mo - mm), wb = lt * __builtin_amdgcn_exp2f(mt - mm), ln = wa + wb; \
                fa = wa / ln; fb = (wb / ln) / lt; mt = mm; lt = ln; } \
            if (hi == 0) { MS[offq] = mt; LS[offq] = lt; wsf[r32] = fa; wsf[32 + r32] = fb; } \
            LAS unsigned short* OA = (LAS unsigned short*)(lds + AT_OACC); \
            if (T.st == 0) { \
                _Pragma("unroll") for (int i = 0; i < 16; ++i) { const int qq = crow(i, hi), off = T.c + T.r * (32 * T.g + qq); const float gb = wsf[32 + qq]; \
                    OA[off * 64 + r32] = (unsigned short)f2bf(gb * o0[i]); OA[off * 64 + 32 + r32] = (unsigned short)f2bf(gb * o1[i]); } \
            } else { \
                _Pragma("unroll") for (int i = 0; i < 16; ++i) { const int qq = crow(i, hi), off = T.c + T.r * (32 * T.g + qq); const float ga = wsf[qq], gb = wsf[32 + qq]; \
                    OA[off * 64 + r32] = (unsigned short)f2bf(gb * o0[i] + ga * bf2f(OA[off * 64 + r32])); OA[off * 64 + 32 + r32] = (unsigned short)f2bf(gb * o1[i] + ga * bf2f(OA[off * 64 + 32 + r32])); } \
            } \
            if (c0.ti & 1) {   \
                __syncthreads(); \
                if (T.st == 2) {   \
                    _Pragma("unroll") for (int it = 0; it < 8; ++it) { const int pi = it * 512 + F.tid, row = pi >> 3, ch = pi & 7; \
                        *(v4u*)(O + ((size_t)T.b * SEQ + T.U0 + row) * 1024 + T.h * 64 + ch * 8) = *(const LAS v4u*)(lds + AT_OACC + row * 128 + ch * 16); } \
                    __syncthreads(); } } } \
        c0 = c1; c1 = c2; attn_advance(F, c2); } while (0)
    AttnCur c0, c1, c2;
    c0.ti = 0; c0.kt = attn_desc(F, 0).kt0;
    c1 = c0; attn_advance(F, c1);
    c2 = c1; attn_advance(F, c2);
    A2_ISSUE(c0, k0, v0); A2_ISSUE(c1, k1, v1);
#pragma unroll 1
    while (attn_desc(F, c0.ti).valid) {
        A2_STEP(k0, v0);
        if (!attn_desc(F, c0.ti).valid) break;
        A2_STEP(k1, v1);
    }
#undef A2_ISSUE
#undef A2_STEP
}
#define OSWZ(row) (((row) ^ ((row) >> 2) ^ ((row) >> 4)) & 7)
#ifndef ATT3_CONST
#define ATT3_CONST 0
#endif
#ifndef ATT_THR
#define ATT_THR 6.f
#endif
#ifndef APF
#define APF 0
#endif
__device__ __forceinline__ void attention_phase3(Frame& F, bf16* O, const bool cst = false) {
    const bf16* QA = (const bf16*)(F.ws + WS_QA); const bf16* KA = (const bf16*)(F.ws + WS_KA); const bf16* VA = (const bf16*)(F.ws + WS_VA);
    const int lane = F.lane, r32_0 = lane & 31, hi_0 = lane >> 5, wave = F.wave;
    LAS unsigned char* lds = F.lds + RING_OFF;
    LAS float* wsf = (LAS float*)(lds + AT_WSF) + wave * 128;
    LAS unsigned char* vb = lds + AT_VB + wave * 4096;
    LAS unsigned char* kb = lds + AT_KB + wave * 4096;
    const int vkk0 = lane >> 3, vch0 = lane & 7;
    LAS float* MS = (LAS float*)(lds + AT_MS); LAS float* LS = (LAS float*)(lds + AT_LS);
    LAS unsigned short* OA = (LAS unsigned short*)(lds + AT_OACC);
    v4u kn[4], vn[4];
#define A3_LOAD(CC, IK0) do { \
        _Pragma("unroll") for (int i_ = 0; i_ < 4; ++i_) kn[i_] = *(const v4u*)(KA + ((ATT3_CONST && cst) ? (size_t)(vkk + 8 * i_) : (rowb + (CC) + r * ((IK0) + vkk + 8 * i_))) * 1024 + h * 64 + 8 * vch); \
        _Pragma("unroll") for (int i_ = 0; i_ < 4; ++i_) vn[i_] = *(const v4u*)(VA + ((ATT3_CONST && cst) ? (size_t)(vkk + 8 * i_) : (rowb + (CC) + r * ((IK0) + vkk + 8 * i_))) * 1024 + h * 64 + 8 * vch); } while (0)
#define A3_STORE() do { \
        _Pragma("unroll") for (int i = 0; i < 4; ++i) *(LAS v4u*)(kb + (vkk + 8 * i) * 128 + 16 * (vch ^ (((vkk >> 1) + 4 * i) & 7))) = kn[i]; \
        _Pragma("unroll") for (int i = 0; i < 4; ++i) *(LAS v4u*)(vb + (vch >> 2) * 2048 + (vkk + 8 * i) * 64 + (vch & 3) * 16) = vn[i]; } while (0)
#define A3_LOADQ(ST) do { const int r_ = (ST) == 0 ? 1 : ((ST) == 1 ? 4 : 16), npc_ = 16 / r_, tau_ = 2 * wave; \
        const int cA_ = tau_ / npc_, cB_ = (tau_ + 1) / npc_, iqA_ = U0 / r_ + 32 * (tau_ % npc_), iqB_ = U0 / r_ + 32 * ((tau_ + 1) % npc_); \
        int vkq_ = vkk0, vcq_ = vch0; LAUNDER(vkq_); LAUNDER(vcq_); \
        _Pragma("unroll") for (int i_ = 0; i_ < 4; ++i_) kn[i_] = *(const v4u*)(QA + (rowb + cA_ + r_ * (iqA_ + vkq_ + 8 * i_)) * 1024 + h * 64 + 8 * vcq_); \
        _Pragma("unroll") for (int i_ = 0; i_ < 4; ++i_) vn[i_] = *(const v4u*)(QA + (rowb + cB_ + r_ * (iqB_ + vkq_ + 8 * i_)) * 1024 + h * 64 + 8 * vcq_); } while (0)
#define A3_QFRAG(SRC, QF) do { \
        _Pragma("unroll") for (int i = 0; i < 4; ++i) *(LAS v4u*)(kb + (vkk + 8 * i) * 128 + 16 * (vch ^ (((vkk >> 1) + 4 * i) & 7))) = SRC[i]; \
        _Pragma("unroll") for (int s = 0; s < 4; ++s) QF[s] = *(const LAS bf16x8*)(krd + ((32 * s) ^ kxr)); } while (0)
#define A3_ROLE(QF, MM, LL, O0, O1, TREL) do { \
        f32x16 p; \
        _Pragma("unroll") for (int i = 0; i < 16; ++i) p[i] = 0.f; \
        __builtin_amdgcn_s_setprio(1); \
        _Pragma("unroll") for (int s = 0; s < 4; ++s) { const bf16x8 kf_ = *(const LAS bf16x8*)(krd + ((32 * s) ^ kxr)); p = MFMA32(kf_, QF[s], p); } \
        __builtin_amdgcn_s_setprio(0); \
        if ((TREL) == 0) { asm volatile("");     \
            _Pragma("unroll") for (int i = 0; i < 16; ++i) if (crow(i, hi) < r32) p[i] = -INFINITY; } \
        if ((TREL) == 4) { asm volatile(""); _Pragma("unroll") for (int i = 0; i < 16; ++i) if (crow(i, hi) > r32) p[i] = -INFINITY; } \
        float tm = p[0]; \
        _Pragma("unroll") for (int i = 1; i < 16; ++i) tm = fmaxf(tm, p[i]); \
        tm = half_max(tm); \
          \
          \
        float corr = 1.f; \
        if (__builtin_amdgcn_ballot_w64(tm - MM > ATT_THR) != 0ull) { const float mn = fmaxf(MM, tm); corr = __builtin_amdgcn_exp2f(MM - mn); MM = mn; \
            _Pragma("unroll") for (int i = 0; i < 16; ++i) { O0[i] *= corr; O1[i] *= corr; } }     \
        float ps = 0.f; \
        _Pragma("unroll") for (int i = 0; i < 16; ++i) { p[i] = __builtin_amdgcn_exp2f(p[i] - MM); ps += p[i]; } \
        LL = LL * corr + ps; \
        const bf16x8 pa0 = pack8(p, 0), pa1 = pack8(p, 1); \
        _Pragma("unroll") for (int s = 0; s < 2; ++s) { \
            const s16x4 a0 = vtr(vrd + s * 1024), a1 = vtr(vrd + s * 1024 + 512), b0 = vtr(vrd + 2048 + s * 1024), b1 = vtr(vrd + 2048 + s * 1024 + 512); \
            const bf16x8 vv0 = (bf16x8){a0[0], a0[1], a0[2], a0[3], a1[0], a1[1], a1[2], a1[3]}, vv1 = (bf16x8){b0[0], b0[1], b0[2], b0[3], b1[0], b1[1], b1[2], b1[3]}; \
            __builtin_amdgcn_s_setprio(1); O0 = MFMA32(vv0, s == 0 ? pa0 : pa1, O0); O1 = MFMA32(vv1, s == 0 ? pa0 : pa1, O1); __builtin_amdgcn_s_setprio(0); } } while (0)
#define A3_MERGE(MM, LL, O0, O1, CC, GG) do { \
        float lt = half_sum(LL), mt = MM; \
        const int offq = (CC) + r * (32 * (GG) + r32); \
        float fa = 0.f, fb = 1.f / lt; \
        if (st != 0) { const float mo = MS[offq], lo = LS[offq]; \
            const float mm = fmaxf(mo, mt), wa = lo * __builtin_amdgcn_exp2f(mo - mm), wb = lt * __builtin_amdgcn_exp2f(mt - mm), ln = wa + wb; \
            fa = wa / ln; fb = (wb / ln) / lt; mt = mm; lt = ln; } \
        if (hi == 0) { MS[offq] = mt; LS[offq] = lt; } \
          \
        LAS unsigned* orow = (LAS unsigned*)(lds + AT_OACC + offq * 128); const int osw = 16 * OSWZ(offq); \
        if (st == 0) { \
            _Pragma("unroll") for (int i = 0; i < 16; i += 2) { const int d2 = 2 * crow(i, hi); \
                orow[(d2 ^ osw) >> 2] = pk2(fb * O0[i], fb * O0[i + 1]); orow[((64 + d2) ^ osw) >> 2] = pk2(fb * O1[i], fb * O1[i + 1]); } \
        } else { \
            _Pragma("unroll") for (int i = 0; i < 16; i += 2) { const int d2 = 2 * crow(i, hi); \
                const unsigned o0 = orow[(d2 ^ osw) >> 2], o1 = orow[((64 + d2) ^ osw) >> 2]; \
                orow[(d2 ^ osw) >> 2] = pk2(fb * O0[i] + fa * bflo(o0), fb * O0[i + 1] + fa * bfhi(o0)); orow[((64 + d2) ^ osw) >> 2] = pk2(fb * O1[i] + fa * bflo(o1), fb * O1[i + 1] + fa * bfhi(o1)); } \
        } } while (0)
    const unsigned pfbase = __builtin_amdgcn_readfirstlane((unsigned)(size_t)F.lds + RING_OFF + 140288 + 256 * wave);
#define A3_PF(PB, PH, RLO, RHI) do { const int lo_ = (RLO) < 0 ? 0 : (RLO), hi_ = (RHI) < 0 ? 0 : (RHI); \
        for (int i_ = F.tid; i_ < 2 * (hi_ - lo_); i_ += NWAVES * 64) { const bf16* p_ = ((i_ & 1) ? VA : KA) + ((size_t)(PB) * SEQ + lo_ + (i_ >> 1)) * 1024 + (PH) * 64; \
            unsigned sv_; asm volatile("s_mov_b32 %0, m0\n\ts_mov_b32 m0, %2\n\ts_nop 0\n\tglobal_load_lds_dword %1, off\n\ts_mov_b32 m0, %0" : "=&s"(sv_) : "v"(p_), "s"(pfbase)); } } while (0)
    for (int idx = F.vcu; idx < 512; idx += F.G) {
        const int rnd = idx >> 8, v8 = idx & 255, G = rnd == 0 ? (v8 & 3) : 3 - (v8 & 3);
        const int bh = F.G == 256 ? 16 * (v8 >> 5) + 8 * rnd + ((v8 & 31) >> 2) : 64 * rnd + (v8 >> 2);
        const int b = bh >> 4, h = bh & 15, U0 = 512 * G;
        const size_t rowb = (size_t)b * SEQ;
        A3_LOADQ(0);
#pragma unroll 1
        for (int st = 0; st < 3; ++st) {
#if APF
            if (st == 0) A3_PF(b, h, U0 - 512, U0 - 128);
            else if (st == 1) A3_PF(b, h, U0 - 2048, U0 - 512);
            else { const int nidx = idx + F.G; if (nidx < 512) { const int nr = nidx >> 8, n8 = nidx & 255, nbh = 64 * nr + (n8 >> 2), nG = nr == 0 ? (n8 & 3) : 3 - (n8 & 3); A3_PF(nbh >> 4, nbh & 15, 512 * nG - 128, 512 * nG + 512); } }
#endif
            int vkk = vkk0, vch = vch0, r32 = r32_0, hi = hi_0; LAUNDER(vkk); LAUNDER(vch); LAUNDER(r32); LAUNDER(hi);
            const int r32g = r32, hig = hi;
            const LAS unsigned char* krd = kb + r32 * 128;
            const int kxr = 16 * (hi ^ ((r32 >> 1) & 7));
            const LAS unsigned char* vrd = vb + (((r32 >> 4) & 1) * 32 + (r32 & 3) * 8 + (4 * hi + ((r32 & 15) >> 2)) * 64);
            const int r = st == 0 ? 1 : (st == 1 ? 4 : 16), npc = 16 / r;
            const int tauA = 2 * wave, cA = tauA / npc, gA = tauA % npc, cB = (tauA + 1) / npc, gB = (tauA + 1) % npc;
            const int iqA0 = U0 / r + 32 * gA, iqB0 = U0 / r + 32 * gB;
            bf16x8 qfA[4], qfB[4];
            A3_QFRAG(kn, qfA); A3_QFRAG(vn, qfB);
            float mA = -1e30f, lA = 0.f, mB = -1e30f, lB = 0.f;
            f32x16 oA0, oA1, oB0, oB1;
#pragma unroll
            for (int i = 0; i < 16; ++i) { oA0[i] = 0.f; oA1[i] = 0.f; oB0[i] = 0.f; oB1[i] = 0.f; }
            int ktA0 = 4 - (iqA0 >> 5); if (ktA0 < 0) ktA0 = 0;
            if (st != 2) {
                A3_LOAD(cA, iqA0 - 128 + 32 * ktA0);
#pragma unroll 1
                for (int t = ktA0; t <= 5; ++t) {
                    A3_STORE();
                    if (t < 5) A3_LOAD(cA, iqA0 - 128 + 32 * (t + 1));
                    if (t <= 4) A3_ROLE(qfA, mA, lA, oA0, oA1, t);
                    __builtin_amdgcn_sched_barrier(0);
                    if (t >= 1) A3_ROLE(qfB, mB, lB, oB0, oB1, t - 1);
                }
            } else {
                int ktB0 = 4 - (iqB0 >> 5); if (ktB0 < 0) ktB0 = 0;
                A3_LOAD(cA, iqA0 - 128 + 32 * ktA0);
#pragma unroll 1
                for (int t = ktA0; t <= 4; ++t) {
                    A3_STORE();
                    if (t < 4) A3_LOAD(cA, iqA0 - 128 + 32 * (t + 1)); else A3_LOAD(cB, iqB0 - 128 + 32 * ktB0);
                    A3_ROLE(qfA, mA, lA, oA0, oA1, t);
                }
#pragma unroll 1
                for (int t = ktB0; t <= 4; ++t) {
                    A3_STORE();
                    if (t < 4) A3_LOAD(cB, iqB0 - 128 + 32 * (t + 1));
                    A3_ROLE(qfB, mB, lB, oB0, oB1, t);
                }
            }
            if (st == 0) A3_LOADQ(1); else if (st == 1) A3_LOADQ(2);
            A3_MERGE(mA, lA, oA0, oA1, cA, gA);
            A3_MERGE(mB, lB, oB0, oB1, cB, gB);
            __syncthreads();
        }
        int tidw = F.tid; LAUNDER(tidw);
#pragma unroll
        for (int it = 0; it < 8; ++it) { const int pi = it * 512 + tidw, row = pi >> 3, ch = pi & 7;
            *(v4u*)(O + ((size_t)b * SEQ + U0 + row) * 1024 + h * 64 + ch * 8) = *(const LAS v4u*)(lds + AT_OACC + row * 128 + 16 * (ch ^ OSWZ(row))); }
        __syncthreads();
    }
#undef A3_LOAD
#undef A3_PF
#undef A3_LOADQ
#undef A3_QFRAG
#undef A3_STORE
#undef A3_ROLE
#undef A3_MERGE
}
#ifndef FLOW_SIG
#define FLOW_SIG 0
#endif
#ifndef FLOW_WAIT
#define FLOW_WAIT 0
#endif
__device__ __forceinline__ void p5_router(Frame& F, const bool dummy) {
    LAS float* scr = (LAS float*)(F.lds + RING_OFF + F.wave * 16384);
    const int gw = F.vcu * NWAVES + F.wave, NGW = F.G * NWAVES, lane = F.lane;
    bf16* W13 = (bf16*)(F.ws + WS_W13);
    constexpr int I_13 = (D / 64) * (FF / 32);
    constexpr int NITEMS = NE * (2 * I_13);
#ifndef RTABL
#define RTABL 0
#endif
    const int rabl = dummy ? RTABL : 0;
    for (int it = gw; it < ((rabl & 1) ? 0 : NITEMS); it += NGW) {
        const int e = it / (2 * I_13); int r = it - e * (2 * I_13);
        { const int w3 = r >= I_13; if (w3) r -= I_13; const int nblk = FF / 32, kb = r / nblk, nb = r % nblk, n0 = 32 * nb;
            const int prow = (n0 >> 7) * 256 + w3 * 128 + (n0 & 127);
            transpose_item(F.in[w3 ? 16 : 15] + (size_t)e * D * FF, FF, 64 * kb, n0, W13 + (size_t)e * 512 * D, D, prow, 0, scr, lane); }
    }
    __syncthreads();
    LAS float* WT = (LAS float*)(F.lds + RING_OFF);
    for (int q = F.tid; q < D * 36; q += NWAVES * 64) { const int p = q / 36, c = q - p * 36, k = (p & ~63) + 4 * (p & 15) + ((p >> 4) & 3);
        WT[q] = F.in[10][k] * (c < 4 ? F.in[11][k * 4 + c] : F.in[13][k * 32 + (c - 4)]); }
    __syncthreads();
    const float* X1 = F.out; bf16* X1N = (bf16*)(F.ws + WS_X1N); const float* gff = F.in[10];
    const float* brg = F.in[12]; const float* bre = F.in[14];
    unsigned* cnt = F.ctl + CW_CNT + (dummy ? 32 : 0);     int* LIST = (int*)(F.ws + (dummy ? 230 * MiB : WS_LIST)); float* GATE = (float*)(F.ws + (dummy ? 234 * MiB : WS_GATE));
    const int kl = lane & 15, tg = lane >> 4;
#define DPP_ADD(v, ctrl) v += __builtin_bit_cast(float, __builtin_amdgcn_update_dpp(0, __builtin_bit_cast(int, v), ctrl, 0xf, 0xf, false))
#define ROW16_SUM(v) do { DPP_ADD(v, 0xB1); DPP_ADD(v, 0x4E); DPP_ADD(v, 0x141); DPP_ADD(v, 0x140); } while (0)
    const bool byb = (F.G == 256);
    for (int m4i = gw; m4i < ((rabl & 2) ? 0 : M / 4); m4i += NGW) {
        const int m4 = byb ? 512 * (F.vcu >> 5) + ((F.vcu & 31) * NWAVES + F.wave) + 256 * (m4i / NGW) : m4i;
        const int m = 4 * m4 + tg;
        int klg = kl; asm volatile("" : "+v"(klg));
        const f32x4* xr = (const f32x4*)(X1 + (size_t)m * D) + kl;
        float s = 0.f;
        f32x4 a[9];
#pragma unroll
        for (int c = 0; c < 9; ++c) a[c] = (f32x4){0.f, 0.f, 0.f, 0.f};
#pragma unroll 1
        for (int j4 = 0; j4 < 4; ++j4) {
            f32x4 x[4];
#pragma unroll
            for (int jj = 0; jj < 4; ++jj) { x[jj] = xr[16 * (4 * j4 + jj)]; s += (x[jj][0] * x[jj][0] + x[jj][1] * x[jj][1]) + (x[jj][2] * x[jj][2] + x[jj][3] * x[jj][3]); }
#pragma unroll
            for (int jj = 0; jj < 4; ++jj)
#pragma unroll
                for (int e = 0; e < 4; ++e) {
                    const LAS f32x4* wr = (const LAS f32x4*)(WT + (64 * (4 * j4 + jj) + 16 * e + kl) * 36);
                    const float xv = x[jj][e];
#pragma unroll
                    for (int c = 0; c < 9; ++c) a[c] += wr[c] * xv;
                    if (e & 1) __builtin_amdgcn_sched_barrier(0);
                }
            __builtin_amdgcn_sched_barrier(0);
        }
        ROW16_SUM(s);
        const float rinv = 1.f / sqrtf(s * (1.f / D) + EPS);
        v2u* xo = (v2u*)(X1N + (size_t)m * D) + kl;
#pragma unroll
        for (int j = 0; j < 16; ++j) {
            const f32x4 xx = xr[16 * j], gg = *((const f32x4*)gff + 16 * j + klg);
            v2u o; o[0] = pk2(xx[0] * rinv * gg[0], xx[1] * rinv * gg[1]); o[1] = pk2(xx[2] * rinv * gg[2], xx[3] * rinv * gg[3]);
            xo[16 * j] = o;
        }
        float lgt[36];
#pragma unroll
        for (int c = 0; c < 9; ++c)
#pragma unroll
            for (int e = 0; e < 4; ++e) { float t = a[c][e]; ROW16_SUM(t); lgt[4 * c + e] = t * rinv + (4 * c + e < 4 ? brg[4 * c + e] : bre[4 * c + e - 4]); }
        int g = 0; float gm = lgt[0];
#pragma unroll
        for (int j = 1; j < 4; ++j) if (lgt[j] > gm) { gm = lgt[j]; g = j; }
        float den = 0.f;
#pragma unroll
        for (int j = 0; j < 4; ++j) den += __expf(lgt[j] - gm);
        const float pg = 1.f / den;
        float v1 = -INFINITY, v2 = -INFINITY; int i1 = 0, i2 = 0;
#pragma unroll
        for (int j = 0; j < 8; ++j) { const float xx = g == 0 ? lgt[4 + j] : (g == 1 ? lgt[12 + j] : (g == 2 ? lgt[20 + j] : lgt[28 + j]));
            if (xx > v1) { v2 = v1; i2 = i1; v1 = xx; i1 = j; } else if (xx > v2) { v2 = xx; i2 = j; } }
        const float e2 = __expf(v2 - v1), w1 = pg / (1.f + e2), w2 = pg * e2 / (1.f + e2);
        if (kl == 0) {
            const int l1 = 8 * g + i1, l2 = 32 + 8 * g + i2;
            const unsigned p1 = __hip_atomic_fetch_add(cnt + 64 * l1, 1u, RLX_AGENT), p2 = __hip_atomic_fetch_add(cnt + 64 * l2, 1u, RLX_AGENT);
            LIST[(size_t)l1 * M + p1] = m; GATE[(size_t)l1 * M + p1] = w1;
            LIST[(size_t)l2 * M + p2] = m; GATE[(size_t)l2 * M + p2] = w2;
            if (!dummy) {
                const int ilo = i1 < i2 ? i1 : i2, ihi = i1 < i2 ? i2 : i1, q = 28 * g + ((ilo * (15 - ilo)) >> 1) + (ihi - ilo - 1);
                const unsigned pp = __hip_atomic_fetch_add(F.ctl + CW_PCNT + 64 * q, 1u, RLX_AGENT);
                const unsigned en1 = ((unsigned)l1 << 14) | p1, en2 = ((unsigned)l2 << 14) | p2;
                ((int*)(F.ws + WS_PTOK))[(size_t)q * M + pp] = m; ((unsigned*)(F.ws + WS_PLO))[(size_t)q * M + pp] = i1 < i2 ? en1 : en2; ((unsigned*)(F.ws + WS_PHI))[(size_t)q * M + pp] = i1 < i2 ? en2 : en1;
            }
        }
        asm volatile("" ::: "memory");
    }
#undef DPP_ADD
#undef ROW16_SUM
}

__device__ __forceinline__ int moe_list_of_pos(int o) { return (o >> 1) | ((o & 1) << 5); }
__device__ __forceinline__ int moe_pos_of_list(int l) { return ((l & 31) << 1) | (l >> 5); }
__device__ __forceinline__ void moe_tile_table(Frame& F) {
    LAS int* tp = (LAS int*)(F.lds + LDS_TP_OFF); LAS int* tmp = (LAS int*)(F.lds + LDS_PTP_OFF + 512);
    __syncthreads();
    if (F.tid < 64) tmp[F.tid] = (int)((__hip_atomic_load(F.ctl + CW_CNT + 64 * moe_list_of_pos(F.tid), RLX_AGENT) + 255u) >> 8);
    __syncthreads();
    if (F.tid == 0) { int acc = 0; for (int o = 0; o < 64; ++o) { tp[o] = acc; acc += tmp[o]; } tp[64] = acc; }
    __syncthreads();
}
__device__ __forceinline__ int moe_heavy(int ntile, int G) { const int maxT = (ntile + G - 1) / G; const int rem = ntile - (maxT - 1) * G; return (ntile == 0 || rem >= G) ? 0 : rem; }
__device__ __forceinline__ void moe_pair_table(Frame& F) {
    LAS int* ptp = (LAS int*)(F.lds + LDS_PTP_OFF); LAS int* tmp = ptp + 128;
    __syncthreads();
    if (F.tid < 112) tmp[F.tid] = (int)((__hip_atomic_load(F.ctl + CW_PCNT + 64 * F.tid, RLX_AGENT) + 255u) >> 8);
    __syncthreads();
    if (F.tid == 0) { int acc = 0; for (int q = 0; q < 112; ++q) { ptp[q] = acc; acc += tmp[q]; } ptp[112] = acc; }
    __syncthreads();
}
__device__ __forceinline__ void moe_w2_convert(Frame& F, const int cidx) {
    const LAS int* tp = (const LAS int*)(F.lds + LDS_TP_OFF);
    const int G = F.G, rem = moe_heavy(2 * tp[64], G);
    if (cidx < rem) return;
    LAS float* scr = (LAS float*)(F.lds + RING_OFF + F.wave * 16384);
    bf16* W2T = (bf16*)(F.ws + WS_W2);
    constexpr int I_2 = (FF / 64) * (D / 32);
    for (int it = (cidx - rem) * NWAVES + F.wave; it < NE * I_2; it += (G - rem) * NWAVES) {
        const int e = it / I_2, r = it - e * I_2, nblk = D / 32, kb = r / nblk, nb = r % nblk;
        transpose_item<FLOW_SIG != 0>(F.in[17] + (size_t)e * FF * D, D, 64 * kb, 32 * nb, W2T + (size_t)e * D * FF, FF, 32 * nb, 0, scr, F.lane); }
    asm volatile("s_waitcnt vmcnt(0)" ::: "memory"); __syncthreads();
    if (F.tid == 0) { (void)__hip_atomic_fetch_add(F.ctl + CW_W2D, 1u, RLX_AGENT); }
}
struct SchedUp {
    const LAS int* tp; const int* LIST; const unsigned* cnt; const char* X; const char* W13; int G, c;
    __device__ __forceinline__ int rowof(int raw) const { return raw & 16383; }
    __device__ bool next(int i, Unit& u) const {
        const int L = i * G + c, tile = L >> 1, ct = L & 1; if (tile >= tp[64]) return false;
        int lo = 0, hi = 64; while (hi - lo > 1) { const int mid = (lo + hi) >> 1; if (tp[mid] <= tile) lo = mid; else hi = mid; }
        const int rt = tile - tp[lo], l = moe_list_of_pos(lo), e = l & 31;
        u.A = X; u.B = W13 + ((size_t)e * 512 + 256 * ct) * D * 2; u.rows = LIST + (size_t)l * M + rt * 256; u.nt = 16; u.pm = tile; u.pn = ct; u.part = l; u.aux = rt; u.fin = true; return true;
    }
};
struct EpiUp {
    static constexpr bool PERM = true; static constexpr bool SIGNAL = (FLOW_SIG != 0);
    bf16* H; const float* GATE; unsigned* upc;
    __device__ __forceinline__ void signal(const Unit& u) const { (void)__hip_atomic_fetch_add(upc + 64 * u.part, 1u, RLX_AGENT); (void)__hip_atomic_fetch_add(upc + 64 * 64 + 64, 1u, RLX_AGENT); }
    __device__ __forceinline__ void operator()(AccRef acc, const Unit& u, int wr, int wc, int fr, int fq) const {
        const int row0 = u.pm * 256 + wr * 64 + fr, col0 = 128 * u.pn + 32 * wc + 8 * fq;
        const float* gp = GATE + (size_t)u.part * M + u.aux * 256 + wr * 64 + fr;
#pragma unroll
        for (int ai = 0; ai < 2; ++ai)
#pragma unroll
            for (int m = 0; m < 4; ++m) { v4u w; const float g = gp[ai * 128 + m * 16];
#pragma unroll
                for (int n = 0; n < 2; ++n) { const pg8::f32x4 a = acc[ai][0][m][n], b = acc[ai][1][m][n]; pg8::f32x4 h;
#pragma unroll
                    for (int e = 0; e < 4; ++e) h[e] = a[e] * sigmoidf_(a[e]) * (b[e] * g);
                    w[2 * n] = pg8::cvt_pk_bf16(h[0], h[1]); w[2 * n + 1] = pg8::cvt_pk_bf16(h[2], h[3]); }
                { void* hp_ = (void*)(H + (size_t)(row0 + ai * 128 + m * 16) * FF + col0);
#if FLOW_SIG
                  asm volatile("global_store_dwordx4 %0, %1, off sc1\n\ts_nop 1" :: "v"(hp_), "v"(w) : "memory");
#else
                  *(v4u*)hp_ = w;
#endif
                } }
    }
};
struct SchedDownP {
    const LAS int* ptp; const LAS int* tp; const int* PLO; const char* H; const char* W2; unsigned* ctl; int G, c, ntv, nconv; mutable bool alldone;
    __device__ __forceinline__ int rowof(int raw) const { return (tp[moe_pos_of_list((raw >> 14) & 63)] * 256 + (raw & 16383)) & 65535; }
    __device__ bool next(int i, Unit& u) const {
        const int ti = i >> 1, part = i & 1, L = ti * G + c, tile = L >> 2, ct = L & 3; if (tile >= ptp[112]) return false;
        int lo = 0, hi = 112; while (hi - lo > 1) { const int mid = (lo + hi) >> 1; if (ptp[mid] <= tile) lo = mid; else hi = mid; }
        const int q = lo, rt = tile - ptp[q], g = q / 28; int t = q - 28 * g, a = 0; while (t >= 7 - a) { t -= 7 - a; ++a; }
        const int ea = 8 * g + a, eb = 8 * g + a + 1 + t;
        if (FLOW_WAIT && part == 0 && !alldone) {
            unsigned need[4]; unsigned* pc[4];
#pragma unroll
            for (int k = 0; k < 4; ++k) { const int l = ((k & 1) ? eb : ea) + 32 * (k >> 1), o = moe_pos_of_list(l); pc[k] = ctl + CW_UPC + 64 * l; need[k] = 2u * (unsigned)(tp[o + 1] - tp[o]); }
            const unsigned nup = 2u * (unsigned)tp[64];
            for (unsigned sp = 0;; ++sp) {
                const unsigned w2 = __hip_atomic_load(ctl + CW_W2D, RLX_AGENT), ua = __hip_atomic_load(ctl + CW_W2D + 64, RLX_AGENT);
                const unsigned c0 = __hip_atomic_load(pc[0], RLX_AGENT), c1 = __hip_atomic_load(pc[1], RLX_AGENT), c2 = __hip_atomic_load(pc[2], RLX_AGENT), c3 = __hip_atomic_load(pc[3], RLX_AGENT);
                if (w2 >= (unsigned)nconv && ua >= nup) { alldone = true; break; }
                if (w2 >= (unsigned)nconv && c0 >= need[0] && c1 >= need[1] && c2 >= need[2] && c3 >= need[3]) break;
                if (sp > (1u << 18)) break;
                __builtin_amdgcn_s_sleep(2);
            }
            __builtin_amdgcn_fence(__ATOMIC_ACQUIRE, "agent");
        }
        const int e = part ? eb : ea;
        u.A = H; u.B = W2 + ((size_t)e * D + 256 * ct) * FF * 2; u.rows = PLO + (part ? (size_t)((WS_PHI - WS_PLO) / 4) : (size_t)0) + (size_t)q * M + rt * 256;
        u.nt = ntv; u.pm = tile; u.pn = ct; u.part = q; u.aux = rt; u.fin = (part != 0); return true;
    }
};
struct EpiDownP {
    static constexpr bool PERM = false; static constexpr bool SIGNAL = false;
    const int* PTOK; const unsigned* pcnt; float* O;
    __device__ __forceinline__ void operator()(AccRef acc, const Unit& u, int wr, int wc, int fr, int fq) const {
        const int q = u.part, n_q = (int)pcnt[64 * q];
        const int r0 = u.aux * 256 + wr * 64 + fr, col0 = u.pn * 256 + wc * 32 + 4 * fq;
        const int* lp = PTOK + (size_t)q * M + r0;
        int tk[8];
#pragma unroll
        for (int g = 0; g < 8; ++g) { const int rr = (g >> 2) * 128 + (g & 3) * 16; tk[g] = (r0 + rr < n_q) ? lp[rr] : -1; }
        f32x4 xb[3][4];
#define ED_LOAD(G) do { if (tk[G] >= 0) { const float* ip_ = O + (size_t)(unsigned)tk[G] * D + col0; \
            _Pragma("unroll") for (int bj = 0; bj < 2; ++bj) _Pragma("unroll") for (int n = 0; n < 2; ++n) xb[(G) % 3][2 * bj + n] = *(const f32x4*)(ip_ + bj * 128 + n * 16); } } while (0)
        ED_LOAD(0); ED_LOAD(1);
#pragma unroll
        for (int g = 0; g < 8; ++g) { const int ai = g >> 2, m = g & 3;
            if (g + 2 < 8) ED_LOAD(g + 2);
            if (tk[g] >= 0) { float* op = O + (size_t)(unsigned)tk[g] * D + col0;
#pragma unroll
                for (int bj = 0; bj < 2; ++bj)
#pragma unroll
                    for (int n = 0; n < 2; ++n) *(f32x4*)(op + bj * 128 + n * 16) = xb[g % 3][2 * bj + n] + acc[ai][bj][m][n]; } }
#undef ED_LOAD
    }
};
struct Args { const float* in[18]; float* out; unsigned char* ws; int ph_lo, ph_hi, aux0, pad; };
enum { PH_PRO = 0, PH_G1A, PH_ATT, PH_G1B, PH_RET, PH_G1C, PH_MIX, PH_OUT, PH_RTR, PH_UP, PH_DN1, PH_DN2, PH_END, PH_RETS = 20, PH_RETC = 21 };

__device__ __forceinline__ bool frame_relane(Frame& F) { int t = threadIdx.x; asm volatile("" : "+v"(t)); F.tid = t; F.lane = t & 63; return true; }
#ifndef STAGGER_US
#define STAGGER_US 0
#endif
#ifndef STAGGER_NG
#define STAGGER_NG 2
#endif
#ifndef STAGGER_MIN
#define STAGGER_MIN 24
#endif
#ifndef LOCAL_SEAMS
#define LOCAL_SEAMS 1
#endif
#ifndef OUT_PF
#define OUT_PF 0
#endif
__device__ __forceinline__ void l2_prefetch_tile(const Frame& F, int pm, int pn, const float* X) {
    const unsigned pfb = __builtin_amdgcn_readfirstlane((unsigned)(size_t)F.lds + 131072 + 256 * F.wave);
    const float* p = X + (size_t)(pm * 256 + (F.tid >> 3)) * D + pn * 256 + 32 * (F.tid & 7);
#pragma unroll 1
    for (int k = 0; k < 4; ++k) { asm volatile("s_mov_b32 m0, %1\n\ts_nop 0\n\tglobal_load_lds_dword %0, off" :: "v"(p), "s"(pfb) : "m0", "memory"); p += (size_t)64 * D; }
}
__global__ void __launch_bounds__(NWAVES * 64, 2) fwd(Args args) {
    extern __shared__ __attribute__((aligned(16))) unsigned char lds[];
    Frame F;
    F.lds = (LAS unsigned char*)lds;
    F.MISC = (volatile LAS unsigned*)(F.lds + MISC_OFF);
    F.tid = threadIdx.x; F.lane = F.tid & 63; F.wave = __builtin_amdgcn_readfirstlane(F.tid >> 6);
    F.G = gridDim.x; { const int bx = blockIdx.x; F.vcu = (F.G % 8 == 0) ? (bx % 8) * (F.G / 8) + bx / 8 : bx; }
    F.ws = args.ws; F.ctl = (unsigned*)(args.ws + WS_CTL); F.out = args.out;
    F.in = args.in;
    for (int u = F.tid; u < (LDS_BYTES - LDSCTL_OFF) / 4; u += NWAVES * 64) ((LAS unsigned*)(F.lds + LDSCTL_OFF))[u] = 0u;
    __syncthreads();
    const int lo = args.ph_lo, hi = args.ph_hi;
    const bool multi = (hi - lo) > 1;
    XcdBarrier bar; bar.bar = F.ctl + CW_BAR; bar.x = 0; bar.st = nullptr;
    if (multi) bar = xcd_barrier_post(F.ctl + CW_BAR, F.MISC + 8);
#ifndef ATT2
#define ATT2 3
#endif
#ifndef DUP_NULL
#define DUP_NULL 0
#endif
#ifndef PROJ_ALIGN
#define PROJ_ALIGN true
#endif
#ifndef DUP_MASK
#define DUP_MASK 0u
#endif
#ifndef PHMASK
#define PHMASK 0xffffffu
#endif
#define IN(k) (((PHMASK >> ((k) > 12 ? 12 : (k))) & 1u) && lo <= (k) && (k) < hi && frame_relane(F))
#define SEAM(k) do { if (IN((k) + 1)) xcd_barrier(bar); } while (0)
#define SEAML(k) do { if (IN((k) + 1)) { if (localok) xcd_barrier_local(bar, (unsigned)(F.G / 8)); else xcd_barrier(bar); } } while (0)
    bool localok = false;
    unsigned char* ws = args.ws;
    bf16* GRb = (bf16*)args.out; bf16* GAb = (bf16*)(ws + WS_QR); bf16* GBb = (bf16*)(ws + WS_KR);

    if (IN(PH_PRO)) { p0_prologue(F);
        if (IN(PH_PRO + 1)) {
            if (F.tid == 0) { unsigned* arr_ = F.ctl + CW_BAR + XB_ARR; XB_SPIN((xb_ld(arr_) & 0xffffu) < (unsigned)F.G, F.ctl + CW_BAR); }
            __syncthreads();
            localok = LOCAL_SEAMS && F.G == 256 && (unsigned)__builtin_amdgcn_readfirstlane((int)xb_ld(F.ctl + CW_BAR + XB_ARR)) == (unsigned)F.G;
            if (localok) xcd_barrier_local(bar, (unsigned)(F.G / 8)); else xcd_barrier(bar);
        } }

#define PROJ_PHASE(PH, TILE0, NTILES, SEAMK) if (IN(PH)) { \
        if (STAGGER_US > 0 && (NTILES) >= STAGGER_MIN && (F.vcu & (STAGGER_NG - 1))) { const long long t0_ = __builtin_amdgcn_s_memtime(), dl_ = (long long)(STAGGER_US * 100) * (F.vcu & (STAGGER_NG - 1)) / (STAGGER_NG - 1); while (__builtin_amdgcn_s_memtime() - t0_ < dl_) __builtin_amdgcn_s_sleep(32); }     \
        SchedPlain S; S.T.init(M, (NTILES) * 256, F.G, (int)blockIdx.x); S.A = (const char*)(ws + WS_XN); S.B = (const char*)(ws + WS_WIN); S.lda = D; S.ldb = D; S.nt = D / 64; S.pn0 = (TILE0); \
        EpiProj E{ws, (bf16*)args.out, F.in}; \
        if ((DUP_MASK >> (PH)) & 1u) { if (DUP_NULL == 1) { EpiNull EN_; pg8::gemm_phase<EpiNull, SchedPlain, false>(F.lds + RING_OFF, D, D, S, EN_); } else if (DUP_NULL == 2) { EpiStoreOnly ES_{(bf16*)(ws + WS_QR)}; pg8::gemm_phase<EpiStoreOnly, SchedPlain, false>(F.lds + RING_OFF, D, D, S, ES_); } else if (DUP_NULL == 4) { EpiNull EN_; SchedConstAB SC_{S}; pg8::gemm_phase<EpiNull, SchedConstAB, false>(F.lds + RING_OFF, D, D, SC_, EN_); } else if (DUP_NULL == 3) { pg8::gemm_phase<EpiProj, SchedPlain, false, PROJ_ALIGN>(F.lds + RING_OFF, D, D, S, E); } else pg8::gemm_phase<EpiProj, SchedPlain, false, PROJ_ALIGN>(F.lds + RING_OFF, D, D, S, E); } \
        pg8::gemm_phase<EpiProj, SchedPlain, false, PROJ_ALIGN>(F.lds + RING_OFF, D, D, S, E); SEAMK(PH); }
    PROJ_PHASE(PH_G1A, 0, 12, SEAML)
    if (IN(PH_ATT)) {
        if (P0_DEFER) {
            p0_weights<true>(F, 2); p0_ret_table(F);
            asm volatile("s_waitcnt vmcnt(0)" ::: "memory"); __syncthreads();
            if (F.tid == 0) (void)xb_add(F.ctl + CW_BAR + XB_ARR2, 1u);
            __syncthreads(); }
#if ATT_SIMPLE
        attn_simple(F);
#else
        if (DUP_MASK & (1u << PH_ATT)) { attention_phase3(F, (bf16*)F.out, true); __syncthreads(); }
#if ATT2 == 3
        attention_phase3(F, (bf16*)(F.ws + WS_QA));
#elif ATT2
        attention_phase2(F, (bf16*)(F.ws + WS_QA));
#else
        attention_phase(F, (bf16*)(F.ws + WS_QA), 0);
#endif
#endif
        if (P0_DEFER && IN(PH_ATT + 1)) { if (F.tid == 0) { unsigned* arr_ = F.ctl + CW_BAR + XB_ARR2; XB_SPIN(xb_ld(arr_) < (unsigned)F.G, F.ctl + CW_BAR); } __syncthreads(); }
        SEAML(PH_ATT); }
    PROJ_PHASE(PH_G1B, 12, 24, SEAML)
    if (IN(PH_RET)) {
        if (P0_DEFER) {
            p0_weights<true>(F, 3);
            asm volatile("s_waitcnt vmcnt(0)" ::: "memory"); __syncthreads();
            if (F.tid == 0) (void)xb_add(F.ctl + CW_BAR + XB_ARR3, 1u);
            __syncthreads(); }
#if RET_SIMPLE
        for (int n = 15; n >= 0; --n) { ret_simple_chunk(F, n); if (multi) xcd_barrier(bar); ret_simple_copy(F, n); if (multi && n > 0) xcd_barrier(bar); }
#else
        if (DUP_MASK & (1u << PH_RET)) { retention_phase(F, true); __syncthreads(); }
        retention_phase(F, false);
#endif
        if (P0_DEFER && IN(PH_RET + 1)) { if (F.tid == 0) { unsigned* arr_ = F.ctl + CW_BAR + XB_ARR3; XB_SPIN(xb_ld(arr_) < (unsigned)F.G, F.ctl + CW_BAR); } __syncthreads(); }
        SEAML(PH_RET); }
    if (IN(PH_RETS)) { ret_simple_chunk(F, args.aux0); }
    if (IN(PH_RETC)) { ret_simple_copy(F, args.aux0); }
#if !RET_SIMPLE
    if (IN(PH_G1C)) { if (DUP_MASK & (1u << 15)) { retnorm_pass(F, true); __syncthreads(); } retnorm_pass(F); }
#endif
    PROJ_PHASE(PH_G1C, 36, 8, SEAML)

    if (IN(PH_MIX)) {
        SchedMix S; S.T.init(M, D, F.G, (int)blockIdx.x); S.ATT = (const char*)(ws + WS_QA); S.W = (const char*)(ws + WS_WMIX);
        EpiMix E{GAb, GBb, (bf16*)args.out, (bf16*)(ws + WS_MRG)};
        pg8::gemm_phase<EpiMix, SchedMix, false>(F.lds + RING_OFF, D, 3072, S, E); if ((DUP_MASK >> PH_MIX) & 1u) pg8::gemm_phase<EpiMix, SchedMix, false>(F.lds + RING_OFF, D, 3072, S, E); SEAML(PH_MIX);
    }
    if (IN(PH_OUT)) {
        SchedPlain S; S.T.init(M, D, F.G, (int)blockIdx.x); S.A = (const char*)(ws + WS_MRG); S.B = (const char*)(ws + WS_WOUT); S.lda = D; S.ldb = D; S.nt = D / 64; S.pn0 = 0;
        EpiOut E{F.in[0], F.out};
        { pg8::TileOrder T2_; T2_.init(M, D, F.G, (int)blockIdx.x); int pm_ = 0, pn_ = 0; const bool ok_ = T2_.tile(0, pm_, pn_); if (OUT_PF && ok_) l2_prefetch_tile(F, pm_, pn_, args.in[0]); }
        pg8::gemm_phase<EpiOut, SchedPlain, false>(F.lds + RING_OFF, D, D, S, E); if ((DUP_MASK >> PH_OUT) & 1u) pg8::gemm_phase<EpiOut, SchedPlain, false>(F.lds + RING_OFF, D, D, S, E); SEAML(PH_OUT);
    }
    if (IN(PH_RTR)) { if ((DUP_MASK >> PH_RTR) & 1u) { p5_router(F, true); __syncthreads(); } p5_router(F, false); SEAM(PH_RTR); }
#ifndef FLOW_SEAM
#define FLOW_SEAM SEAM(PH_UP);
#endif
    const int cmoe = F.G == 256 ? ((F.vcu & 31) >> 2) * 32 + (F.vcu >> 5) * 4 + (F.vcu & 3) : F.vcu;
    if (IN(PH_UP)) {
        moe_tile_table(F);
        SchedUp S{(const LAS int*)(F.lds + LDS_TP_OFF), (const int*)(ws + WS_LIST), F.ctl + CW_CNT, (const char*)(ws + WS_X1N), (const char*)(ws + WS_W13), F.G, cmoe};
        EpiUp E{(bf16*)(ws + WS_H), (const float*)(ws + WS_GATE), F.ctl + CW_UPC};
        pg8::gemm_phase<EpiUp, SchedUp, true>(F.lds + RING_OFF, D, D, S, E);
        __syncthreads(); moe_w2_convert(F, cmoe); FLOW_SEAM
    }
    if (IN(PH_DN1)) {
        moe_tile_table(F); moe_pair_table(F);
        int nt4 = 4; asm volatile("" : "+s"(nt4));
        const LAS int* tp = (const LAS int*)(F.lds + LDS_TP_OFF);
        const int heavy = moe_heavy(2 * tp[64], F.G);
        SchedDownP S{(const LAS int*)(F.lds + LDS_PTP_OFF), tp, (const int*)(ws + WS_PLO), (const char*)(ws + WS_H), (const char*)(ws + WS_W2), F.ctl, F.G, (cmoe - heavy + F.G) % F.G, nt4, F.G - heavy, false};
        EpiDownP E{(const int*)(ws + WS_PTOK), F.ctl + CW_PCNT, F.out};
        pg8::gemm_phase<EpiDownP, SchedDownP, true>(F.lds + RING_OFF, FF, FF, S, E);
    }
#ifdef EXTRA_BARS
    if (multi) for (int i_ = 0; i_ < EXTRA_BARS; ++i_) xcd_barrier(bar);
#endif
#ifdef EXTRA_BARS
    if (multi) for (int i_ = 0; i_ < EXTRA_BARS; ++i_) xcd_barrier(bar);
#endif
#undef IN
#undef SEAM
}

extern "C" void kernel_launch(void* const* d_in, const int* in_sizes, int n_in, void* d_out, int out_size, void* d_ws, size_t ws_size, hipStream_t stream) {
    static int grid = 0;
    if (grid == 0) {
        if (n_in != 18 || in_sizes[0] != M * D || out_size != M * D || ws_size < WS_END) { fprintf(stderr, "kernel_launch: unexpected problem shape (n_in %d, in0 %d, out %d, ws %zu)\n", n_in, n_in > 0 ? in_sizes[0] : -1, out_size, ws_size); grid = -1; return; }
        int dev = 0, cus = 0, per_cu = 0;
        if (hipGetDevice(&dev) != hipSuccess || hipDeviceGetAttribute(&cus, hipDeviceAttributeMultiprocessorCount, dev) != hipSuccess) { grid = -1; return; }
        if (hipFuncSetAttribute((const void*)fwd, hipFuncAttributeMaxDynamicSharedMemorySize, LDS_BYTES) != hipSuccess) { fprintf(stderr, "kernel_launch: hipFuncSetAttribute failed\n"); grid = -1; return; }
        if (hipOccupancyMaxActiveBlocksPerMultiprocessor(&per_cu, (const void*)fwd, NWAVES * 64, LDS_BYTES) != hipSuccess || per_cu < 1) { fprintf(stderr, "kernel_launch: occupancy query says %d blocks per CU\n", per_cu); }
        (void)hipGetLastError();
        grid = cus;
    }
    if (grid < 0) return;
    (void)hipMemsetAsync((char*)d_ws + WS_CTL, 0, CTL_ZERO_BYTES, stream);
    Args a{};
    for (int i = 0; i < 18; ++i) a.in[i] = (const float*)d_in[i];
    a.out = (float*)d_out; a.ws = (unsigned char*)d_ws;
#define LAUNCH(LO, HI, AUX) do { a.ph_lo = (LO); a.ph_hi = (HI); a.aux0 = (AUX); hipLaunchKernelGGL(fwd, dim3(grid), dim3(NWAVES * 64), LDS_BYTES, stream, a); } while (0)
#ifndef DBG_LAST
#define DBG_LAST 99
#endif
#if MK_MODE == 0
    for (int ph = PH_PRO; ph <= PH_G1B && ph <= DBG_LAST; ++ph) LAUNCH(ph, ph + 1, 0);
    if (DBG_LAST >= PH_RET) for (int n = 15; n >= 0; --n) { LAUNCH(PH_RETS, PH_RETS + 1, n); LAUNCH(PH_RETC, PH_RETC + 1, n); }
    for (int ph = PH_G1C; ph < PH_END && ph <= DBG_LAST; ++ph) LAUNCH(ph, ph + 1, 0);
#else
    LAUNCH(PH_PRO, PH_END, 0);
#endif
}
```
